# Optimizing an MI355X kernel written in HIP

```python
import math
import jax, jax.numpy as jnp
from jax import lax
import numpy as np

D_MODEL = 1024
BATCH = 8
SEQ = 2048
DEPTH = 2

N_META = 16
CHUNK = 128
D_MIX = D_MODEL
RET_HEADS = 4
RET_DK = 128
RET_DV = 128
RET_WIDTH = RET_HEADS * RET_DV
RET_THETA = 10000.0
DIFF_HEADS = 4
DIFF_D = 64
DIFF_DV = 2 * DIFF_D
DIFF_WIDTH = DIFF_HEADS * DIFF_DV
ROPE_THETA = 500000.0
ROPE_DIMS = DIFF_D // 4
D_FF = 2816
EPS = 1e-6

IN_SIZES = (
    RET_HEADS * RET_DK,
    RET_HEADS * RET_DK,
    RET_WIDTH,
    RET_WIDTH,
    DIFF_HEADS * 2 * DIFF_D,
    DIFF_HEADS * 2 * DIFF_D,
    DIFF_WIDTH,
)
D_IN = sum(IN_SIZES)

kernel_name = "hymba_retnet_diffattn_macaron"


def rmsnorm(x, g):
    xf = x.astype(jnp.float32)
    y = xf * lax.rsqrt(jnp.mean(xf * xf, axis=-1, keepdims=True) + EPS)
    return (y * g.astype(jnp.float32)).astype(x.dtype)


def swiglu(x, w_gate, w_up, w_down):
    return (jax.nn.silu(x @ w_gate) * (x @ w_up)) @ w_down


def retention_rotate(x, pos):
    d = x.shape[-1]
    angle = RET_THETA ** (-jnp.linspace(0.0, 1.0, d // 2, dtype=jnp.float32))
    freqs = pos[:, None] * angle[None, :]
    cos = jnp.cos(freqs)[None, :, None, :]
    sin = jnp.sin(freqs)[None, :, None, :]
    x1, x2 = x[..., 0::2], x[..., 1::2]
    out = jnp.stack([x1 * cos - x2 * sin, x1 * sin + x2 * cos], axis=-1)
    return out.reshape(x.shape)


def partial_rope(x, pos):
    r = ROPE_DIMS
    inv = ROPE_THETA ** (-jnp.arange(0, r, 2, dtype=jnp.float32) / r)
    freqs = pos[:, None] * inv[None, :]
    emb = jnp.concatenate([freqs, freqs], axis=-1)
    cos = jnp.cos(emb)[None, :, None, None, :]
    sin = jnp.sin(emb)[None, :, None, None, :]
    xr, xp = x[..., :r], x[..., r:]
    rot = jnp.concatenate([-xr[..., r // 2:], xr[..., :r // 2]], axis=-1)
    return jnp.concatenate([xr * cos + rot * sin, xp], axis=-1)


def retention_group(q, k, v, g, gn_w):
    B, T = q.shape[0], q.shape[1]
    f32 = jnp.float32
    pos = jnp.arange(T, dtype=f32)
    q = retention_rotate(q.reshape(B, T, RET_HEADS, RET_DK).astype(f32), pos)
    k = retention_rotate(k.reshape(B, T, RET_HEADS, RET_DK).astype(f32), pos) * (RET_DK ** -0.5)
    v = v.reshape(B, T, RET_HEADS, RET_DV).astype(f32)

    n_chunks = -(-T // CHUNK)
    pad = n_chunks * CHUNK - T

    def to_chunks(t):
        t = jnp.pad(t, ((0, 0), (pad, 0), (0, 0), (0, 0)))
        return t.reshape(B, n_chunks, CHUNK, t.shape[2], t.shape[3]).transpose(0, 3, 1, 2, 4)

    qc, kc, vc = to_chunks(q), to_chunks(k), to_chunks(v)

    log_gamma = jnp.log(1.0 - 2.0 ** (-5.0 - jnp.arange(RET_HEADS, dtype=f32)))
    idx = jnp.arange(CHUNK, dtype=f32)
    rel = idx[:, None] - idx[None, :]
    decay_intra = jnp.where(rel >= 0, jnp.exp(log_gamma[:, None, None] * jnp.maximum(rel, 0.0)), 0.0)
    k_decay = jnp.exp(log_gamma[:, None] * (CHUNK - 1 - idx)[None, :])
    q_decay = jnp.exp(log_gamma[:, None] * (idx + 1.0)[None, :])
    chunk_decay = jnp.exp(log_gamma * CHUNK)

    scores = jnp.einsum('bhnid,bhnjd->bhnij', qc, kc) * decay_intra[None, :, None]
    o_intra = jnp.einsum('bhnij,bhnje->bhnie', scores, vc)

    chunk_state = jnp.einsum('bhnjd,bhnje,hj->bhnde', kc, vc, k_decay)

    def step(R, s):
        return R * chunk_decay[None, :, None, None] + s, R

    R0 = jnp.zeros((B, RET_HEADS, RET_DK, RET_DV), f32)
    _, R_prev = lax.scan(step, R0, jnp.moveaxis(chunk_state, 2, 0))
    R_prev = jnp.moveaxis(R_prev, 0, 2)
    o_cross = jnp.einsum('bhnid,bhnde,hi->bhnie', qc, R_prev, q_decay)

    o = (o_intra + o_cross).transpose(0, 2, 3, 1, 4).reshape(B, n_chunks * CHUNK, RET_HEADS, RET_DV)[:, pad:]
    mu = jnp.mean(o, axis=-1, keepdims=True)
    var = jnp.mean((o - mu) ** 2, axis=-1, keepdims=True)
    o = ((o - mu) * lax.rsqrt(var + EPS)).reshape(B, T, RET_WIDTH) * gn_w.astype(f32)
    return (jax.nn.silu(g.astype(f32)) * o).astype(g.dtype)


def diff_attention_group(q, k, v, subln_w, lq1, lk1, lq2, lk2, lambda_init):
    B, T = q.shape[0], q.shape[1]
    f32 = jnp.float32
    pos = jnp.arange(T, dtype=f32)
    q = partial_rope(q.reshape(B, T, DIFF_HEADS, 2, DIFF_D).astype(f32), pos)
    k = partial_rope(k.reshape(B, T, DIFF_HEADS, 2, DIFF_D).astype(f32), pos)
    v = v.reshape(B, T, DIFF_HEADS, DIFF_DV).astype(f32)

    lam = (jnp.exp(jnp.sum(lq1.astype(f32) * lk1.astype(f32)))
           - jnp.exp(jnp.sum(lq2.astype(f32) * lk2.astype(f32))) + lambda_init)

    n_blocks = -(-T // CHUNK)
    pad = n_blocks * CHUNK - T
    q = jnp.pad(q, ((0, 0), (pad, 0), (0, 0), (0, 0), (0, 0))).transpose(0, 2, 3, 1, 4)
    k = jnp.pad(k, ((0, 0), (pad, 0), (0, 0), (0, 0), (0, 0))).transpose(0, 2, 3, 1, 4)
    v = jnp.pad(v, ((0, 0), (pad, 0), (0, 0), (0, 0))).transpose(0, 2, 1, 3)
    scale = DIFF_D ** -0.5

    outs = []
    for nb in range(n_blocks):
        n_keys = (nb + 1) * CHUNK
        qb = q[:, :, :, nb * CHUNK:(nb + 1) * CHUNK]
        s = jnp.einsum('bhmid,bhmjd->bhmij', qb, k[:, :, :, :n_keys]) * scale
        qi = nb * CHUNK + jnp.arange(CHUNK)
        kj = jnp.arange(n_keys)
        allowed = (kj[None, :] <= qi[:, None]) & (kj[None, :] >= pad)
        p = jax.nn.softmax(jnp.where(allowed, s, -1e30), axis=-1)
        a = p[:, :, 0] - lam * p[:, :, 1]
        outs.append(jnp.einsum('bhij,bhje->bhie', a, v[:, :, :n_keys]))
    o = jnp.concatenate(outs, axis=2)[:, :, pad:].transpose(0, 2, 1, 3)
    o = o * lax.rsqrt(jnp.mean(o * o, axis=-1, keepdims=True) + EPS) * subln_w.astype(f32)
    o = o * (1.0 - lambda_init)
    return o.reshape(B, T, DIFF_WIDTH).astype(q.dtype)


def setup_inputs(seed: int = 0) -> dict:
    key = jax.random.key(seed)
    ks = jax.random.split(key, 24)
    f32 = jnp.float32
    nrm = lambda k, shape, s: jax.random.normal(k, shape, f32) * s
    gain = lambda k, shape: 1.0 + 0.1 * jax.random.normal(k, shape, f32)
    return {
        "x": jax.random.normal(ks[0], (BATCH, SEQ, D_MODEL), f32),
        "meta_tokens": nrm(ks[1], (N_META, D_MODEL), 1.0),
        "ffn1_norm": gain(ks[2], (DEPTH, D_MODEL)),
        "ffn1_w_gate": nrm(ks[3], (DEPTH, D_MODEL, D_FF), D_MODEL ** -0.5),
        "ffn1_w_up": nrm(ks[4], (DEPTH, D_MODEL, D_FF), D_MODEL ** -0.5),
        "ffn1_w_down": nrm(ks[5], (DEPTH, D_FF, D_MODEL), D_FF ** -0.5),
        "mix_norm": gain(ks[6], (DEPTH, D_MODEL)),
        "w_in": nrm(ks[7], (DEPTH, D_MODEL, D_IN), D_MODEL ** -0.5),
        "ret_gn_w": gain(ks[8], (DEPTH, RET_WIDTH)),
        "diff_subln_w": gain(ks[9], (DEPTH, DIFF_DV)),
        "diff_lambda_q1": nrm(ks[10], (DEPTH, DIFF_D), 0.1),
        "diff_lambda_k1": nrm(ks[11], (DEPTH, DIFF_D), 0.1),
        "diff_lambda_q2": nrm(ks[12], (DEPTH, DIFF_D), 0.1),
        "diff_lambda_k2": nrm(ks[13], (DEPTH, DIFF_D), 0.1),
        "w_out": nrm(ks[14], (DEPTH, D_MIX, D_MODEL), D_MIX ** -0.5),
        "ffn2_norm": gain(ks[15], (DEPTH, D_MODEL)),
        "ffn2_w_gate": nrm(ks[16], (DEPTH, D_MODEL, D_FF), D_MODEL ** -0.5),
        "ffn2_w_up": nrm(ks[17], (DEPTH, D_MODEL, D_FF), D_MODEL ** -0.5),
        "ffn2_w_down": nrm(ks[18], (DEPTH, D_FF, D_MODEL), D_FF ** -0.5),
        "final_norm": gain(ks[19], (D_MODEL,)),
    }


def reference(x, meta_tokens, ffn1_norm, ffn1_w_gate, ffn1_w_up, ffn1_w_down,
              mix_norm, w_in, ret_gn_w, diff_subln_w, diff_lambda_q1, diff_lambda_k1,
              diff_lambda_q2, diff_lambda_k2, w_out, ffn2_norm, ffn2_w_gate,
              ffn2_w_up, ffn2_w_down, final_norm):
    B = x.shape[0]
    meta = jnp.broadcast_to(meta_tokens.astype(x.dtype)[None], (B, N_META, D_MODEL))
    h = jnp.concatenate([meta, x], axis=1)
    offs = np.cumsum((0,) + IN_SIZES)

    for l in range(DEPTH):
        h = h + 0.5 * swiglu(rmsnorm(h, ffn1_norm[l]), ffn1_w_gate[l], ffn1_w_up[l], ffn1_w_down[l])

        proj = rmsnorm(h, mix_norm[l]) @ w_in[l]
        parts = [proj[..., int(offs[i]):int(offs[i + 1])] for i in range(len(IN_SIZES))]
        rq, rk, rv, rg, dq, dk, dv = parts
        lambda_init = 0.8 - 0.6 * math.exp(-0.3 * l)
        y_ret = retention_group(rq, rk, rv, rg, ret_gn_w[l])
        y_diff = diff_attention_group(dq, dk, dv, diff_subln_w[l], diff_lambda_q1[l],
                                      diff_lambda_k1[l], diff_lambda_q2[l], diff_lambda_k2[l],
                                      lambda_init)
        h = h + jnp.concatenate([y_ret, y_diff], axis=-1) @ w_out[l]

        h = h + 0.5 * swiglu(rmsnorm(h, ffn2_norm[l]), ffn2_w_gate[l], ffn2_w_up[l], ffn2_w_down[l])

    h = rmsnorm(h, final_norm)
    return h[:, N_META:]
```

```cpp
#include <hip/hip_runtime.h>
#include <cstdio>
#include <cstdint>
#include <cmath>
#include <hip/hip_bf16.h>

#define GAS __attribute__((address_space(1)))
#define LAS __attribute__((address_space(3)))
typedef unsigned short bf16;
typedef short bf16x8 __attribute__((ext_vector_type(8)));
typedef float f32x4 __attribute__((ext_vector_type(4)));
typedef unsigned u32x4 __attribute__((ext_vector_type(4)));
typedef unsigned u32x2 __attribute__((ext_vector_type(2)));
typedef _Float16 h2_t __attribute__((ext_vector_type(2)));
__device__ __forceinline__ h2_t as_h2(unsigned w) { return __builtin_bit_cast(h2_t, w); }

constexpr int D = 1024, FF = 2816, DIN = 3584, SEQ = 2048, NBATCH = 8, NMETA = 16;
constexpr int NREAL = NBATCH * SEQ;
constexpr int MROW0 = NREAL + 48;
constexpr int MP = NREAL + 256;
constexpr int NPOS = NMETA + SEQ;
constexpr float EPS = 1e-6f;
constexpr float C2 = 0.125f * 1.4426950408889634f;
constexpr int SEG_RQ = 0, SEG_RK = 512, SEG_RV = 1024, SEG_RG = 1536, SEG_DQ = 2048, SEG_DK = 2560, SEG_DV = 3072, YCOL = 1536;

constexpr size_t MiB = 1u << 20;
constexpr size_t WS_CTL = 0, CTL_BYTES = 2 * MiB, CTL_MEMSET = 64 * 1024;
constexpr size_t CTL_SS = 256 * 1024;
typedef unsigned long long u64;
constexpr float SS_SCALE = 16777216.f, SS_INV = 1.f / (16777216.f * 1024.f);
static_assert(CTL_SS + (size_t)7 * (NREAL + 256) * 8 <= 2 * MiB, "ctl");
constexpr size_t WS_TAB = 2 * MiB;
constexpr size_t TAB_P = (size_t)NPOS * 64 * 8, TAB_LAM = TAB_P + (size_t)NPOS * 8 * 8;
constexpr size_t WS_W = 4 * MiB;
constexpr size_t W_GU1 = 0, W_D1 = W_GU1 + (size_t)2 * FF * D * 2, W_IN = W_D1 + (size_t)D * FF * 2, W_OUT = W_IN + (size_t)DIN * D * 2,
                 W_GU2 = W_OUT + (size_t)D * D * 2, W_D2 = W_GU2 + (size_t)2 * FF * D * 2, W_END = W_D2 + (size_t)D * FF * 2;
static_assert(W_END == 42 * MiB, "weights");
constexpr size_t WS_HB = 46 * MiB;
constexpr size_t WS_PROJ = WS_HB + (size_t)MP * D * 2;
constexpr size_t WS_OP = WS_PROJ + (size_t)MP * DIN * 2;
constexpr size_t WS_HM = WS_OP + (size_t)MP * D * 2;
constexpr size_t WS_RP = WS_HM + (size_t)256 * D * 4;
constexpr size_t WS_ACTM = WS_RP + (size_t)512 * 16384 * 2;
constexpr size_t WS_XCH = WS_ACTM + (size_t)NMETA * FF * 2 + 256;
constexpr size_t WS_END = WS_XCH + (size_t)NREAL * 4 * 4;
static_assert(WS_END <= 256 * MiB, "d_ws map");

struct Params {
    const float* in[20];
    float* out;
    unsigned char* ws;
    int ph_lo, ph_hi;
};

__device__ __forceinline__ unsigned f2bf(float f) { unsigned u = __builtin_bit_cast(unsigned, f); return (u + 0x7fffu + ((u >> 16) & 1u)) >> 16; }
typedef float f32x2_t __attribute__((ext_vector_type(2))); typedef __bf16 bf16x2_t __attribute__((ext_vector_type(2)));
__device__ __forceinline__ unsigned pk2(float lo, float hi) { f32x2_t v = {lo, hi}; bf16x2_t b = __builtin_convertvector(v, bf16x2_t); return __builtin_bit_cast(unsigned, b); }
__device__ __forceinline__ float bflo(unsigned u) { return __builtin_bit_cast(float, u << 16); }
__device__ __forceinline__ float bfhi(unsigned u) { return __builtin_bit_cast(float, u & 0xffff0000u); }
__device__ __forceinline__ float bf2f(bf16 b) { return __builtin_bit_cast(float, (unsigned)b << 16); }
__device__ __forceinline__ int perm32(int rho) { const int n = rho >> 4, i = rho & 15; return 8 * (i >> 2) + 4 * n + (i & 3); }
__device__ __forceinline__ float wave_sum(float v) {
#pragma unroll
    for (int o = 1; o < 64; o <<= 1) v += __shfl_xor(v, o);
    return v;
}
__device__ __forceinline__ float silu(float x) { return x * __builtin_amdgcn_rcpf(1.f + __expf(-x)); }
typedef float f32x2 __attribute__((ext_vector_type(2)));
__device__ __forceinline__ f32x2 sigmoid2(f32x2 x) { const f32x2 t = x * (-1.4426950408889634f); f32x2 e; e.x = __builtin_amdgcn_exp2f(t.x); e.y = __builtin_amdgcn_exp2f(t.y);
    const f32x2 d = e + 1.0f; f32x2 r; r.x = __builtin_amdgcn_rcpf(d.x); r.y = __builtin_amdgcn_rcpf(d.y); return r; }
__device__ __forceinline__ float ss_rstd(unsigned long long v) { const float f = __builtin_fmaf((float)(unsigned)(v >> 32), 4294967296.f, (float)(unsigned)v); return __builtin_amdgcn_rsqf(f * (1.f / (16777216.f * 1024.f)) + 1e-6f); }
__device__ __forceinline__ float* hrow(float* out, float* hm, int row) {
    return row < NREAL ? out + (size_t)row * D : hm + (size_t)(row - NREAL) * D;
}
__device__ __forceinline__ float lambda_init(int l) { return l == 0 ? 0.2f : 0.8f - 0.6f * 0.7408182206817179f; }
__device__ __forceinline__ float log2gamma(int h) { return h == 0 ? -0.04580368961312479f : h == 1 ? -0.02272007650008353f : h == 2 ? -0.011315313227834146f : -0.005646563141142063f; }
__device__ __forceinline__ int row_pos(int row) { return row < NREAL ? NMETA + (row & (SEQ - 1)) : (row >= MROW0 && row < MROW0 + NMETA ? row - MROW0 : 0); }
__device__ __forceinline__ int row_il(int row) { return row < NREAL ? (row & 127) : (row >= MROW0 && row < MROW0 + NMETA ? 112 + row - MROW0 : 0); }

__device__ __forceinline__ void stage_prologue(const Params& p, int gw, int ngw, int lane, int gtid, int ngt) {
    const float* x = p.in[0]; const float* meta = p.in[1];
    bf16* hb = (bf16*)(p.ws + WS_HB); u64* ss0 = (u64*)(p.ws + WS_CTL + CTL_SS);
    for (int r0 = gw; r0 < NREAL; r0 += 4 * ngw) {
        f32x4 v[4][4]; int row[4];
#pragma unroll
        for (int k = 0; k < 4; ++k) { row[k] = r0 + k * ngw < NREAL ? r0 + k * ngw : r0;
#pragma unroll
            for (int j = 0; j < 4; ++j) v[k][j] = *(const f32x4*)(x + (size_t)row[k] * D + 4 * lane + 256 * j); }
#pragma unroll
        for (int k = 0; k < 4; ++k) {
            float s = 0.f;
#pragma unroll
            for (int j = 0; j < 4; ++j) s += (v[k][j].x * v[k][j].x + v[k][j].y * v[k][j].y) + (v[k][j].z * v[k][j].z + v[k][j].w * v[k][j].w);
            s = wave_sum(s);
            if (k == 0 || row[k] != r0) {
#pragma unroll
                for (int j = 0; j < 4; ++j) { u32x2 w; w.x = pk2(v[k][j].x, v[k][j].y); w.y = pk2(v[k][j].z, v[k][j].w); *(u32x2*)(hb + (size_t)row[k] * D + 4 * lane + 256 * j) = w; }
                if (lane == 0) ss0[row[k]] = (u64)(s * SS_SCALE);
            }
        }
    }
    for (int row = NREAL + gw; row < MP; row += ngw) {
        f32x4 v[4];
        const bool ismeta = (row >= MROW0 && row < MROW0 + NMETA);
        const float* src = meta + (size_t)(ismeta ? row - MROW0 : 0) * D;
        float s = 0.f;
#pragma unroll
        for (int j = 0; j < 4; ++j) {
            v[j] = ismeta ? *(const f32x4*)(src + 4 * lane + 256 * j) : (f32x4){0.f, 0.f, 0.f, 0.f};
            s += (v[j].x * v[j].x + v[j].y * v[j].y) + (v[j].z * v[j].z + v[j].w * v[j].w);
        }
        s = wave_sum(s);
        float* hr = (float*)(p.ws + WS_HM) + (size_t)(row - NREAL) * D;
#pragma unroll
        for (int j = 0; j < 4; ++j) {
            *(f32x4*)(hr + 4 * lane + 256 * j) = v[j];
            u32x2 w; w.x = pk2(v[j].x, v[j].y); w.y = pk2(v[j].z, v[j].w);
            *(u32x2*)(hb + (size_t)row * D + 4 * lane + 256 * j) = w;
        }
        if (lane == 0) ss0[row] = (u64)(s * SS_SCALE);
    }
    for (int e = gtid; e < 6 * MP; e += ngt) ss0[MP + e] = 0ull;
    for (int e = gtid; e < 48 * DIN / 8; e += ngt) *(u32x4*)((bf16*)(p.ws + WS_PROJ) + (size_t)NREAL * DIN + (size_t)e * 8) = (u32x4){0u, 0u, 0u, 0u};
    h2_t* rtab = (h2_t*)(p.ws + WS_TAB); h2_t* ptab = (h2_t*)(p.ws + WS_TAB + TAB_P); float* lam = (float*)(p.ws + WS_TAB + TAB_LAM);
    for (int e = gtid; e < NPOS * 64; e += ngt) {
        const int pos = e >> 6, i = e & 63;
        const double ang = exp(-log(10000.0) * (double)i / 63.0), f = (double)pos * ang;
        rtab[e] = (h2_t){(_Float16)(float)cos(f), (_Float16)(float)sin(f)};
    }
    for (int e = gtid; e < NPOS * 8; e += ngt) {
        const int pos = e >> 3, j = e & 7;
        const double inv = exp(-log(500000.0) * (double)j / 8.0), f = (double)pos * inv;
        ptab[e] = (h2_t){(_Float16)(float)cos(f), (_Float16)(float)sin(f)};
    }
    if (gtid < 2) {
        const int l = gtid; float s1 = 0.f, s2 = 0.f;
        for (int i = 0; i < 64; ++i) { s1 += p.in[10][l * 64 + i] * p.in[11][l * 64 + i]; s2 += p.in[12][l * 64 + i] * p.in[13][l * 64 + i]; }
        lam[l] = expf(s1) - expf(s2) + lambda_init(l);
    }
}

__device__ __forceinline__ void conv_item(const float* W, int K, int N, bf16* WT, int item, int gu_half  , int mode,
                                          const float* ks, const float* ks2, float mul2, LAS float* scr, int lane) {
    const int nblk = N / 32, kb = item / nblk, nb = item % nblk, k0 = 64 * kb, n0 = 32 * nb;
    const int row0 = gu_half < 0 ? n0 : 256 * (n0 / 128) + (n0 % 128) + 128 * gu_half;
    f32x4 v[8];
#pragma unroll
    for (int i = 0; i < 8; ++i) v[i] = *(const f32x4*)(W + (size_t)(k0 + 8 * i + (lane >> 3)) * N + n0 + 4 * (lane & 7));
#pragma unroll
    for (int i = 0; i < 8; ++i) {
        const int kk = 8 * i + (lane >> 3), k = k0 + kk;
        float sc = 1.f;
        if (mode == 1) sc = ks[k];
        else if (mode == 2) sc = k < 512 ? ks[k] : ks2[(k - 512) & 127] * mul2;
        LAS float* d = scr + kk * 33 + 4 * (lane & 7);
        d[0] = v[i].x * sc; d[1] = v[i].y * sc; d[2] = v[i].z * sc; d[3] = v[i].w * sc;
    }
    asm volatile("s_waitcnt lgkmcnt(0)" ::: "memory");
    const int c = lane & 7;
#pragma unroll
    for (int j = 0; j < 4; ++j) {
        const int n = (lane >> 3) + 8 * j; const LAS float* s = scr + (8 * c) * 33 + n;
        u32x4 o; o.x = pk2(s[0 * 33], s[1 * 33]); o.y = pk2(s[2 * 33], s[3 * 33]); o.z = pk2(s[4 * 33], s[5 * 33]); o.w = pk2(s[6 * 33], s[7 * 33]);
        *(u32x4*)(WT + (size_t)(row0 + n) * K + k0 + 8 * c) = o;
    }
    asm volatile("s_waitcnt lgkmcnt(0)" ::: "memory");
}
constexpr int I_GU = (D / 64) * (FF / 32), I_D = (FF / 64) * (D / 32), I_IN = (D / 64) * (DIN / 32), I_O = (D / 64) * (D / 32);
__device__ __forceinline__ void convert_set(const Params& p, int l, int mask, LAS float* scr, int w, int nw, int lane) {
    unsigned char* wb = p.ws + WS_W;
    const size_t oGU = (size_t)l * D * FF, oD = (size_t)l * FF * D;
    if (mask & 1) for (int r = w; r < 2 * I_GU; r += nw) { const int half = r >= I_GU; conv_item((half ? p.in[4] : p.in[3]) + oGU, D, FF, (bf16*)(wb + W_GU1), r - half * I_GU, half, 1, p.in[2] + l * D, nullptr, 0.f, scr, lane); }
    if (mask & 2) for (int r = w; r < I_D; r += nw) conv_item(p.in[5] + oD, FF, D, (bf16*)(wb + W_D1), r, -1, 0, nullptr, nullptr, 0.f, scr, lane);
    if (mask & 4) for (int r = w; r < I_IN; r += nw) conv_item(p.in[7] + (size_t)l * D * DIN, D, DIN, (bf16*)(wb + W_IN), r, -1, 1, p.in[6] + l * D, nullptr, 0.f, scr, lane);
    if (mask & 8) for (int r = w; r < I_O; r += nw) conv_item(p.in[14] + (size_t)l * D * D, D, D, (bf16*)(wb + W_OUT), r, -1, 2, p.in[8] + l * 512, p.in[9] + l * 128, 1.f - lambda_init(l), scr, lane);
    if (mask & 16) for (int r = w; r < 2 * I_GU; r += nw) { const int half = r >= I_GU; conv_item((half ? p.in[17] : p.in[16]) + oGU, D, FF, (bf16*)(wb + W_GU2), r - half * I_GU, half, 1, p.in[15] + l * D, nullptr, 0.f, scr, lane); }
    if (mask & 32) for (int r = w; r < I_D; r += nw) conv_item(p.in[18] + oD, FF, D, (bf16*)(wb + W_D2), r, -1, 0, nullptr, nullptr, 0.f, scr, lane);
}

struct EpiSwiGLU {
    typedef u64 Ctx;
    const u64* ss; bf16* act;
    __device__ __forceinline__ Ctx load(int row, int) const { return ss[row]; }
    __device__ __forceinline__ void pair(int row, int oc, const Ctx& c, f32x4 g0, f32x4 g1, f32x4 u0, f32x4 u1) const {
        const float rs = ss_rstd(c), rs2 = rs * rs;
        const f32x2 g[4] = {(f32x2){g0.x, g0.y}, (f32x2){g0.z, g0.w}, (f32x2){g1.x, g1.y}, (f32x2){g1.z, g1.w}}, uu[4] = {(f32x2){u0.x, u0.y}, (f32x2){u0.z, u0.w}, (f32x2){u1.x, u1.y}, (f32x2){u1.z, u1.w}};
        f32x2 o[4];
#pragma unroll
        for (int k = 0; k < 4; ++k) o[k] = ((g[k] * uu[k]) * rs2) * sigmoid2(g[k] * rs);
        u32x4 w; w.x = pk2(o[0].x, o[0].y); w.y = pk2(o[1].x, o[1].y); w.z = pk2(o[2].x, o[2].y); w.w = pk2(o[3].x, o[3].y);
        *(u32x4*)(act + (size_t)row * FF + oc) = w;
    }
};
template <int MODE> struct EpiResidT {
    struct Ctx { f32x4 a, b; };
    static constexpr bool PER_BJ = true;
    static constexpr int RB = MODE == 1 ? 2 : 4;
    const float* base; float* out; const float* hm; bf16* hb; u64* ssn; float scale;
    __device__ __forceinline__ Ctx load(int row, int col0) const {
        Ctx c;
        if (MODE == 1) { const float* br = row < NREAL ? base + (size_t)row * D + col0 : hm + (size_t)(row - NREAL) * D + col0; c.a = *(const f32x4*)br; c.b = *(const f32x4*)(br + 4); }
        else { const u32x4 w = *(const u32x4*)(hb + (size_t)row * D + col0); c.a = __builtin_bit_cast(f32x4, w); }
        return c;
    }
    __device__ __forceinline__ void row8(int row, int col0, const Ctx& c, f32x4 v0, f32x4 v1) const {
        f32x4 ra, rb;
        if (MODE == 1) { ra = c.a; rb = c.b; }
        else { const u32x4 w = __builtin_bit_cast(u32x4, c.a); ra = (f32x4){bflo(w.x), bfhi(w.x), bflo(w.y), bfhi(w.y)}; rb = (f32x4){bflo(w.z), bfhi(w.z), bflo(w.w), bfhi(w.w)}; }
        const f32x4 a = ra + v0 * scale, b = rb + v1 * scale;
        if (MODE == 2) { if (row < NREAL) { float* hr = out + (size_t)row * D + col0; *(f32x4*)hr = a; *(f32x4*)(hr + 4) = b; } }
        else { u32x4 w; w.x = pk2(a.x, a.y); w.y = pk2(a.z, a.w); w.z = pk2(b.x, b.y); w.w = pk2(b.z, b.w); *(u32x4*)(hb + (size_t)row * D + col0) = w; }
        float s = (a.x * a.x + a.y * a.y) + (a.z * a.z + a.w * a.w) + (b.x * b.x + b.y * b.y) + (b.z * b.z + b.w * b.w);
        s += __shfl_xor(s, 16); s += __shfl_xor(s, 32);
        if ((threadIdx.x & 48) == 0) atomicAdd(ssn + row, (u64)(s * SS_SCALE));
    }
};
struct EpiInProj {
    struct Ctx { u64 ss; u32x4 ta, tb; };
    static constexpr bool PER_BJ = false;
    static constexpr int RB = 4;
    const u64* ss; bf16* proj; const h2_t* rtab; const h2_t* ptab;
    __device__ __forceinline__ Ctx load(int row, int col0) const {
        Ctx c; c.ss = ss[row];
        const int seg = col0 >> 9, pos = row_pos(row);
        const u32x4* ta = seg <= 1 ? (const u32x4*)(rtab + pos * 64 + ((col0 & 127) >> 1)) : (const u32x4*)(ptab + pos * 8);
        c.ta = ta[0]; c.tb = ((const u32x4*)(ptab + pos * 8))[1];
        return c;
    }
    __device__ __forceinline__ void row8(int row, int col0, const Ctx& c, f32x4 v0, f32x4 v1) const {
        const float rs = ss_rstd(c.ss);
        float x[8];
#pragma unroll
        for (int j = 0; j < 4; ++j) { x[j] = v0[j] * rs; x[4 + j] = v1[j] * rs; }
        const int seg = col0 >> 9;
        if (seg <= 1) {
            const int h = (col0 >> 7) & 3;
            const float e = (float)(row_il(row) + 1) * log2gamma(h);
            const float f = seg == 0 ? __builtin_amdgcn_exp2f(e) : __builtin_amdgcn_exp2f(-e) * 0.08838834764831845f;
#define ROT2(j, W) { const h2_t cs = as_h2(W); const float a = x[2 * (j)], b = x[2 * (j) + 1], co = (float)cs.x, si = (float)cs.y; x[2 * (j)] = (a * co - b * si) * f; x[2 * (j) + 1] = (a * si + b * co) * f; }
            ROT2(0, c.ta.x) ROT2(1, c.ta.y) ROT2(2, c.ta.z) ROT2(3, c.ta.w)
#undef ROT2
        } else if (seg == 3) {
#pragma unroll
            for (int j = 0; j < 8; j += 2) { const f32x2 xv = (f32x2){x[j], x[j + 1]}, sv = xv * sigmoid2(xv); x[j] = sv.x; x[j + 1] = sv.y; }
        } else if (seg == 4 || seg == 5) {
            const int d0 = col0 & 63;
            float y[8];
#pragma unroll
            for (int j = 0; j < 8; ++j) y[j] = __shfl_xor(x[j], 16);
            if (d0 < 16) {
#define ROPE1(j, W) { const h2_t cs = as_h2(W); const float co = (float)cs.x, si = (float)cs.y; x[j] = d0 == 0 ? x[j] * co - y[j] * si : x[j] * co + y[j] * si; }
                ROPE1(0, c.ta.x) ROPE1(1, c.ta.y) ROPE1(2, c.ta.z) ROPE1(3, c.ta.w) ROPE1(4, c.tb.x) ROPE1(5, c.tb.y) ROPE1(6, c.tb.z) ROPE1(7, c.tb.w)
#undef ROPE1
            }
            if (seg == 4) {
#pragma unroll
                for (int j = 0; j < 8; ++j) x[j] *= C2;
            }
        }
        u32x4 w; w.x = pk2(x[0], x[1]); w.y = pk2(x[2], x[3]); w.z = pk2(x[4], x[5]); w.w = pk2(x[6], x[7]);
        *(u32x4*)(proj + (size_t)row * DIN + col0) = w;
    }
};

template <bool PAIRED, class Epi>
__device__ __forceinline__ void gemm_naive(const bf16* A, int lda, const bf16* Bt, int M, int N, int K, const Epi& E, int gw, int ngw, int lane) {
    const int fr = lane & 15, fq = lane >> 4;
    const int ngrp = PAIRED ? N / 64 : N / 32;
    const int nitems = (M / 16) * ngrp;
    for (int it = gw; it < nitems; it += ngw) {
        const int rb = it / ngrp, cg = it % ngrp;
        int col0;
        if (PAIRED) { const int oc = cg * 32; col0 = (oc / 128) * 256 + (oc % 128); } else col0 = cg * 32;
        f32x4 acc[4];
#pragma unroll
        for (int n = 0; n < 4; ++n) acc[n] = (f32x4){0.f, 0.f, 0.f, 0.f};
        const bf16* ap = A + (size_t)(rb * 16 + fr) * lda + fq * 8;
        const bf16* bp0 = Bt + (size_t)(col0 + perm32(fr)) * K + fq * 8;
        const bf16* bp1 = Bt + (size_t)(col0 + perm32(16 + fr)) * K + fq * 8;
        for (int k = 0; k < K; k += 32) {
            const bf16x8 a = *(const bf16x8*)(ap + k);
            const bf16x8 b0 = *(const bf16x8*)(bp0 + k), b1 = *(const bf16x8*)(bp1 + k);
            acc[0] = __builtin_amdgcn_mfma_f32_16x16x32_bf16(b0, a, acc[0], 0, 0, 0);
            acc[1] = __builtin_amdgcn_mfma_f32_16x16x32_bf16(b1, a, acc[1], 0, 0, 0);
            if (PAIRED) {
                const bf16x8 b2 = *(const bf16x8*)(bp0 + (size_t)128 * K + k), b3 = *(const bf16x8*)(bp1 + (size_t)128 * K + k);
                acc[2] = __builtin_amdgcn_mfma_f32_16x16x32_bf16(b2, a, acc[2], 0, 0, 0);
                acc[3] = __builtin_amdgcn_mfma_f32_16x16x32_bf16(b3, a, acc[3], 0, 0, 0);
            }
        }
        const int row = rb * 16 + fr;
        if constexpr (PAIRED) { const auto c = E.load(row, cg * 32 + 8 * fq); E.pair(row, cg * 32 + 8 * fq, c, acc[0], acc[1], acc[2], acc[3]); }
        else { const auto c = E.load(row, col0 + 8 * fq); E.row8(row, col0 + 8 * fq, c, acc[0], acc[1]); }
    }
}

namespace pg8 {
#define PG8_LAS __attribute__((address_space(3)))
typedef unsigned short bf16_t;
constexpr int BM = 256, BK = 64, HALF = 128, HTB = HALF * BK * 2  , STAGE_BYTES = 8 * HTB, NXCD = 8, WGM = 8;

__host__ __device__ __forceinline__ int lds_byte(int r, int c) { const int st = (r >> 4) * 2 + (c >> 5), rr = r & 15, cc = c & 31, ob = rr * 64 + cc * 2; return st * 1024 + (ob ^ (((ob >> 9) & 1) << 5)); }
__host__ __device__ __forceinline__ void stage_rc(int b, int& R, int& C) { const int st = b / 1024, sb = b % 1024, swz = sb ^ (((sb >> 9) & 1) << 5); R = (st >> 1) * 16 + swz / 64; C = (st & 1) * 32 + (swz % 64) / 2; }

struct Unit { int pm, pn; };
struct Gemm { const bf16_t* A; const bf16_t* Bt; int M, N, K, lda; };

struct StaticOrder {
    int nM, nN, nwg, G, c;
    __host__ __device__ void init(int M, int N, int G_, int c_) { nM = M / BM; nN = N / BM; nwg = nM * nN; G = G_; c = c_; }
    __host__ __device__ bool next(int i, Unit& u) const {
        const long L = (long)i * G + c; if (L >= nwg) return false;
        int wgid = (int)L; { const int q = nwg / NXCD, r = nwg % NXCD, xcd = wgid % NXCD, off = wgid / NXCD; wgid = (xcd < r ? xcd * (q + 1) : r * (q + 1) + (xcd - r) * q) + off; }
        const int nig = WGM * nN, gid = wgid / nig, fm = gid * WGM, gsz = (nM - fm) < WGM ? (nM - fm) : WGM;
        u.pm = fm + ((wgid % nig) % gsz); u.pn = (wgid % nig) / gsz; return true;
    }
    __device__ __forceinline__ void a_ready(const Unit&) const {}
    __device__ __forceinline__ void done(const Unit&) const {}
};

template <class Epi, class Sched, bool ALIGN_EPI = false, bool SP2 = false>
__device__ __forceinline__ void gemm_phase(PG8_LAS unsigned char* lds, const Gemm g, const Sched& S, const Epi& E) {
    const int tid = threadIdx.x, wid = __builtin_amdgcn_readfirstlane(tid >> 6), lane = tid & 63, wr = wid >> 2, wc = wid & 3, fr = lane & 15, fq = lane >> 4;
    const int K = g.K, nt = K / BK, lda = g.lda;
    unsigned voffA[2], voffB[2];
#pragma unroll
    for (int i = 0; i < 2; ++i) { int R, C; stage_rc(tid * 16 + i * 8192, R, C); const int Rb = Epi::PERM ? ((R & ~31) + perm32(R & 31)) : R;
        voffA[i] = (unsigned)(R * lda + C) * 2u; voffB[i] = (unsigned)(Rb * K + C) * 2u; }
    const size_t kstep = (size_t)(BK * 2);
    const size_t hstep = (size_t)HALF * K * 2, hstepA = (size_t)HALF * lda * 2;
    const size_t tstep = 2 * hstep, tstepA = 2 * hstepA;
    const unsigned ldsw = (unsigned)wid * 1024u;
    const int aoff = lds_byte(wr * 64 + fr, fq * 8), boff = lds_byte(wc * 32 + fr, fq * 8);
#define PG8_SA(b, h) (((b) * 2 + (h)) * HTB)
#define PG8_SB(b, h) ((4 + (b) * 2 + (h)) * HTB)
#define PG8_STAGE(bufoff, gbase, voff) do { _Pragma("unroll") for (int _i = 0; _i < 2; ++_i) \
        __builtin_amdgcn_global_load_lds((const unsigned*)((const char*)(gbase) + (voff)[_i]), (PG8_LAS unsigned*)(lds + (bufoff) + ldsw + _i * 8192), 16, 0, 0); } while (0)
#define PG8_LDA(dst, b, h) do { _Pragma("unroll") for (int m = 0; m < 4; ++m) _Pragma("unroll") for (int k = 0; k < 2; ++k) dst[m][k] = *(const PG8_LAS bf16x8*)(lds + PG8_SA(b, h) + aoff + m * 2048 + k * 1024); } while (0)
#define PG8_LDB(dst, b, h) do { _Pragma("unroll") for (int n = 0; n < 2; ++n) _Pragma("unroll") for (int k = 0; k < 2; ++k) dst[n][k] = *(const PG8_LAS bf16x8*)(lds + PG8_SB(b, h) + boff + n * 2048 + k * 1024); } while (0)
#define PG8_MMA(ai, bj, At, Bt) do { __builtin_amdgcn_s_setprio(1); _Pragma("unroll") for (int m = 0; m < 4; ++m) _Pragma("unroll") for (int n = 0; n < 2; ++n) _Pragma("unroll") for (int k = 0; k < 2; ++k) \
        acc[ai][bj][m][n] = __builtin_amdgcn_mfma_f32_16x16x32_bf16(Bt[n][k], At[m][k], acc[ai][bj][m][n], 0, 0, 0); __builtin_amdgcn_s_setprio(0); } while (0)
#define PG8_WAIT_V(n) asm volatile("s_waitcnt vmcnt(" #n ")" ::: "memory")
#define PG8_WAIT_L(n) asm volatile("s_waitcnt lgkmcnt(" #n ")" ::: "memory")
#define PG8_BAR __builtin_amdgcn_s_barrier()
#define PG8_SCHED __builtin_amdgcn_sched_barrier(0)
    Unit cur, nxt; int ui = 0;
    if (!S.next(0, cur)) return;
    f32x4 acc[2][2][4][2];
#pragma unroll
    for (int a = 0; a < 2; ++a)
#pragma unroll
        for (int b = 0; b < 2; ++b)
#pragma unroll
            for (int m = 0; m < 4; ++m)
#pragma unroll
                for (int n = 0; n < 2; ++n) acc[a][b][m][n] = (f32x4){0.f, 0.f, 0.f, 0.f};
    bf16x8 At[4][2], B0[2][2], B1[2][2];
    const char* cA = (const char*)g.A + (size_t)cur.pm * tstepA; const char* cB = (const char*)g.Bt + (size_t)cur.pn * tstep;
    S.a_ready(cur);
    if constexpr (SP2) {
        PG8_STAGE(PG8_SB(0, 0), cB, voffB); PG8_STAGE(PG8_SB(0, 1), cB + hstep, voffB); PG8_STAGE(PG8_SA(0, 0), cA, voffA); PG8_STAGE(PG8_SA(0, 1), cA + hstepA, voffA);
        if (wr == 1) PG8_BAR;
        PG8_WAIT_V(2); PG8_BAR;
        PG8_STAGE(PG8_SB(1, 0), cB + kstep, voffB); PG8_STAGE(PG8_SA(1, 0), cA + kstep, voffA); PG8_STAGE(PG8_SB(1, 1), cB + hstep + kstep, voffB);
        PG8_WAIT_V(6); PG8_BAR;
    } else {
        PG8_STAGE(PG8_SB(0, 0), cB, voffB); PG8_STAGE(PG8_SA(0, 0), cA, voffA); PG8_STAGE(PG8_SB(0, 1), cB + hstep, voffB); PG8_STAGE(PG8_SA(0, 1), cA + hstepA, voffA);
        if (wr == 1) PG8_BAR;
        PG8_WAIT_V(4); PG8_BAR;
        PG8_STAGE(PG8_SB(1, 0), cB + kstep, voffB); PG8_STAGE(PG8_SA(1, 0), cA + kstep, voffA); PG8_STAGE(PG8_SB(1, 1), cB + hstep + kstep, voffB);
        PG8_WAIT_V(6); PG8_BAR;
    }
    for (;;) {
        const bool has_next = S.next(ui + 1, nxt);
        const char* nA = has_next ? (const char*)g.A + (size_t)nxt.pm * tstepA : cA; const char* nB = has_next ? (const char*)g.Bt + (size_t)nxt.pn * tstep : cB;
        for (int t = 0; t < nt; t += 2) {
            const bool last = (t == nt - 2);
            const char* a1 = cA + (size_t)(t + 1) * kstep;
            const char* a2 = last ? nA : cA + (size_t)(t + 2) * kstep; const char* b2 = last ? nB : cB + (size_t)(t + 2) * kstep;
            const char* a3 = a2 + kstep; const char* b3 = b2 + kstep;
            if (last && has_next) S.a_ready(nxt);
            if constexpr (SP2) {
            PG8_LDB(B0, 0, 0); PG8_LDB(B1, 0, 1); PG8_SCHED; PG8_LDA(At, 0, 0); PG8_STAGE(PG8_SA(1, 1), a1 + hstepA, voffA);
            PG8_WAIT_V(8); PG8_WAIT_L(0); PG8_BAR; PG8_MMA(0, 0, At, B0); PG8_MMA(0, 1, At, B1); PG8_BAR; PG8_SCHED;
            PG8_LDA(At, 0, 1); PG8_STAGE(PG8_SB(0, 0), b2, voffB); PG8_STAGE(PG8_SB(0, 1), b2 + hstep, voffB); PG8_STAGE(PG8_SA(0, 0), a2, voffA);
            PG8_WAIT_V(8); PG8_WAIT_L(0); PG8_BAR; PG8_MMA(1, 0, At, B0); PG8_MMA(1, 1, At, B1); PG8_BAR; PG8_SCHED;
            PG8_LDB(B0, 1, 0); PG8_LDB(B1, 1, 1); PG8_SCHED; PG8_LDA(At, 1, 0); PG8_STAGE(PG8_SA(0, 1), a2 + hstepA, voffA);
            PG8_WAIT_V(8); PG8_WAIT_L(0); PG8_BAR; PG8_MMA(0, 0, At, B0); PG8_MMA(0, 1, At, B1); PG8_BAR; PG8_SCHED;
            PG8_LDA(At, 1, 1); PG8_STAGE(PG8_SB(1, 0), b3, voffB); PG8_STAGE(PG8_SB(1, 1), b3 + hstep, voffB); PG8_STAGE(PG8_SA(1, 0), a3, voffA);
            PG8_WAIT_V(8); PG8_WAIT_L(0); PG8_BAR; PG8_MMA(1, 0, At, B0); PG8_MMA(1, 1, At, B1); PG8_BAR; PG8_SCHED;
            } else {
            PG8_LDB(B0, 0, 0); PG8_SCHED; PG8_LDA(At, 0, 0); PG8_STAGE(PG8_SA(1, 1), a1 + hstepA, voffA);
            PG8_WAIT_L(8); PG8_BAR; PG8_WAIT_L(0); PG8_MMA(0, 0, At, B0); PG8_BAR; PG8_SCHED;
            PG8_LDB(B1, 0, 1); PG8_STAGE(PG8_SB(0, 0), b2, voffB);
            PG8_BAR; PG8_WAIT_L(0); PG8_MMA(0, 1, At, B1); PG8_BAR;
            PG8_LDA(At, 0, 1); PG8_STAGE(PG8_SA(0, 0), a2, voffA);
            PG8_BAR; PG8_WAIT_L(0); PG8_MMA(1, 0, At, B0); PG8_BAR; PG8_SCHED;
            PG8_STAGE(PG8_SB(0, 1), b2 + hstep, voffB);
            PG8_WAIT_V(6); PG8_BAR; PG8_MMA(1, 1, At, B1); PG8_BAR;
            PG8_LDB(B0, 1, 0); PG8_SCHED; PG8_LDA(At, 1, 0); PG8_STAGE(PG8_SA(0, 1), a2 + hstepA, voffA);
            PG8_WAIT_L(8); PG8_BAR; PG8_WAIT_L(0); PG8_MMA(0, 0, At, B0); PG8_BAR; PG8_SCHED;
            PG8_LDB(B1, 1, 1); PG8_STAGE(PG8_SB(1, 0), b3, voffB);
            PG8_BAR; PG8_WAIT_L(0); PG8_MMA(0, 1, At, B1); PG8_BAR;
            PG8_LDA(At, 1, 1); PG8_STAGE(PG8_SA(1, 0), a3, voffA);
            PG8_BAR; PG8_WAIT_L(0); PG8_MMA(1, 0, At, B0); PG8_BAR; PG8_SCHED;
            PG8_STAGE(PG8_SB(1, 1), b3 + hstep, voffB);
            PG8_WAIT_V(6); PG8_BAR; PG8_MMA(1, 1, At, B1); PG8_BAR;
            }
        }
        if constexpr (ALIGN_EPI) { if (wr == 0) PG8_BAR; }
        if constexpr (!Epi::AFTER_DRAIN) { E(acc, cur, wr, wc, fr, fq); S.done(cur); }
        if (!has_next) break;
#pragma unroll
        for (int a = 0; a < 2; ++a)
#pragma unroll
            for (int b = 0; b < 2; ++b)
#pragma unroll
                for (int m = 0; m < 4; ++m)
#pragma unroll
                    for (int n = 0; n < 2; ++n) acc[a][b][m][n] = (f32x4){0.f, 0.f, 0.f, 0.f};
        cur = nxt; cA = nA; cB = nB; ++ui;
        if constexpr (ALIGN_EPI) { if (wr == 1) PG8_BAR; }
    }
    PG8_WAIT_V(0);
    if constexpr (!ALIGN_EPI) { if (wr == 0) PG8_BAR; }
    PG8_BAR;
    if constexpr (Epi::AFTER_DRAIN) { E.fused(acc, cur, wr, wc, fr, fq, lds, wid, lane); S.done(cur); }
#undef PG8_SA
#undef PG8_SB
#undef PG8_STAGE
#undef PG8_LDA
#undef PG8_LDB
#undef PG8_MMA
#undef PG8_WAIT_V
#undef PG8_WAIT_L
#undef PG8_BAR
#undef PG8_SCHED
}
}

template <bool PAIRED, class Epi>
__device__ __forceinline__ void gemm_meta(LAS unsigned char* lds, const bf16* A, int lda, const bf16* Bt, int N, int K, const Epi& E, int first, int stride, int wave, int lane, unsigned* arrive = nullptr) {
    const int fr = lane & 15, fq = lane >> 4;
    const int ngrp = PAIRED ? N / 64 : N / 32, ksl = K / 8;
    if (first < 0) return;
    constexpr int NF = PAIRED ? 4 : 2;
    LAS f32x4* red = (LAS f32x4*)lds;
    for (int cg = first; cg < ngrp; cg += stride) {
        int col0;
        if (PAIRED) { const int oc = cg * 32; col0 = (oc / 128) * 256 + (oc % 128); } else col0 = cg * 32;
        f32x4 acc[NF];
#pragma unroll
        for (int n = 0; n < NF; ++n) acc[n] = (f32x4){0.f, 0.f, 0.f, 0.f};
        const bf16* ap = A + (size_t)(MROW0 + fr) * lda + wave * ksl + fq * 8;
        const bf16* bp0 = Bt + (size_t)(col0 + perm32(fr)) * K + wave * ksl + fq * 8;
        const bf16* bp1 = Bt + (size_t)(col0 + perm32(16 + fr)) * K + wave * ksl + fq * 8;
#pragma unroll 4
        for (int k = 0; k < ksl; k += 32) {
            const bf16x8 a = *(const bf16x8*)(ap + k);
            const bf16x8 b0 = *(const bf16x8*)(bp0 + k), b1 = *(const bf16x8*)(bp1 + k);
            acc[0] = __builtin_amdgcn_mfma_f32_16x16x32_bf16(b0, a, acc[0], 0, 0, 0);
            acc[1] = __builtin_amdgcn_mfma_f32_16x16x32_bf16(b1, a, acc[1], 0, 0, 0);
            if constexpr (PAIRED) {
                const bf16x8 b2 = *(const bf16x8*)(bp0 + (size_t)128 * K + k), b3 = *(const bf16x8*)(bp1 + (size_t)128 * K + k);
                acc[2] = __builtin_amdgcn_mfma_f32_16x16x32_bf16(b2, a, acc[2], 0, 0, 0);
                acc[3] = __builtin_amdgcn_mfma_f32_16x16x32_bf16(b3, a, acc[3], 0, 0, 0);
            }
        }
#pragma unroll
        for (int n = 0; n < NF; ++n) red[(wave * NF + n) * 64 + lane] = acc[n];
        __syncthreads();
        if (wave == 0) {
#pragma unroll
            for (int w = 1; w < 8; ++w)
#pragma unroll
                for (int n = 0; n < NF; ++n) acc[n] = acc[n] + red[(w * NF + n) * 64 + lane];
            const int row = MROW0 + fr;
            if constexpr (PAIRED) { const auto c = E.load(row, cg * 32 + 8 * fq); E.pair(row, cg * 32 + 8 * fq, c, acc[0], acc[1], acc[2], acc[3]); }
            else { const auto c = E.load(row, col0 + 8 * fq); E.row8(row, col0 + 8 * fq, c, acc[0], acc[1]); }
        }
        __syncthreads();
    }
    if (arrive && first < ngrp) {
        asm volatile("s_waitcnt vmcnt(0)" ::: "memory");
        __syncthreads();
        if (threadIdx.x == 0) { __builtin_amdgcn_fence(__ATOMIC_RELEASE, "agent"); asm volatile("s_waitcnt vmcnt(0)" ::: "memory");
            __hip_atomic_fetch_add(arrive, (unsigned)((ngrp - 1 - first) / stride + 1), __ATOMIC_RELAXED, __HIP_MEMORY_SCOPE_AGENT); }
    }
}
__device__ __forceinline__ void meta_wait(unsigned* cnt, unsigned need) {
    if (threadIdx.x == 0) {
        unsigned sp = 0;
        while (__hip_atomic_load(cnt, __ATOMIC_RELAXED, __HIP_MEMORY_SCOPE_AGENT) < need) { __builtin_amdgcn_s_sleep(2); if (++sp > (1u << 18)) break; }
        __builtin_amdgcn_fence(__ATOMIC_ACQUIRE, "agent"); asm volatile("s_waitcnt vmcnt(0)" ::: "memory");
    }
    __syncthreads();
}

template <class F> struct EpiRow8 {
    static constexpr bool PERM = true, AFTER_DRAIN = false; F f;
    __device__ __forceinline__ void operator()(const f32x4 (&acc)[2][2][4][2], const pg8::Unit& u, int wr, int wc, int fr, int fq) const {
        const int colb = u.pn * 256 + wc * 32 + 8 * fq;
#pragma unroll
        for (int ai = 0; ai < 2; ++ai)
#pragma unroll
            for (int mb = 0; mb < 4; mb += F::RB) {
                const int row0 = u.pm * 256 + ai * 128 + wr * 64 + fr;
                typename F::Ctx c[F::RB][F::PER_BJ ? 2 : 1];
#pragma unroll
                for (int m = 0; m < F::RB; ++m)
#pragma unroll
                    for (int bj = 0; bj < (F::PER_BJ ? 2 : 1); ++bj) c[m][bj] = f.load(row0 + (mb + m) * 16, colb + bj * 128);
#pragma unroll
                for (int m = 0; m < F::RB; ++m)
#pragma unroll
                    for (int bj = 0; bj < 2; ++bj) f.row8(row0 + (mb + m) * 16, colb + bj * 128, c[m][F::PER_BJ ? bj : 0], acc[ai][bj][mb + m][0], acc[ai][bj][mb + m][1]);
            }
    }
};
template <class F> struct EpiPair {
    static constexpr bool PERM = true, AFTER_DRAIN = false; F f;
    __device__ __forceinline__ void operator()(const f32x4 (&acc)[2][2][4][2], const pg8::Unit& u, int wr, int wc, int fr, int fq) const {
        const int oc = u.pn * 128 + wc * 32 + 8 * fq;
        typename F::Ctx c[2][4];
#pragma unroll
        for (int ai = 0; ai < 2; ++ai)
#pragma unroll
            for (int m = 0; m < 4; ++m) c[ai][m] = f.load(u.pm * 256 + ai * 128 + wr * 64 + m * 16 + fr, oc);
#pragma unroll
        for (int ai = 0; ai < 2; ++ai)
#pragma unroll
            for (int m = 0; m < 4; ++m) { const int row = u.pm * 256 + ai * 128 + wr * 64 + m * 16 + fr;
                f.pair(row, oc, c[ai][m], acc[ai][0][m][0], acc[ai][0][m][1], acc[ai][1][m][0], acc[ai][1][m][1]); }
    }
};

struct EpiFinalFused {
    static constexpr bool PERM = true, AFTER_DRAIN = true;
    const bf16* hb; float* out; const float* gw; unsigned* xch; unsigned* cnt  ; float scale;
    __device__ __forceinline__ void fused(f32x4 (&acc)[2][2][4][2], const pg8::Unit& u, int wr, int wc, int fr, int fq, LAS unsigned char* lds, int wid, int lane) const {
        LAS float* P = (LAS float*)lds;
        LAS float* S = (LAS float*)(lds + 4096);
        const int colb = u.pn * 256 + wc * 32 + 8 * fq;
#pragma unroll
        for (int ai = 0; ai < 2; ++ai) {
            u32x4 rw[4][2];
#pragma unroll
            for (int m = 0; m < 4; ++m)
#pragma unroll
                for (int bj = 0; bj < 2; ++bj) rw[m][bj] = *(const u32x4*)(hb + (size_t)(u.pm * 256 + ai * 128 + wr * 64 + m * 16 + fr) * D + colb + bj * 128);
#pragma unroll
            for (int m = 0; m < 4; ++m) {
                float s = 0.f;
#pragma unroll
                for (int bj = 0; bj < 2; ++bj) { const u32x4 w = rw[m][bj];
                    const f32x4 a = (f32x4){bflo(w.x), bfhi(w.x), bflo(w.y), bfhi(w.y)} + acc[ai][bj][m][0] * scale, b = (f32x4){bflo(w.z), bfhi(w.z), bflo(w.w), bfhi(w.w)} + acc[ai][bj][m][1] * scale;
                    acc[ai][bj][m][0] = a; acc[ai][bj][m][1] = b;
                    s += (a.x * a.x + a.y * a.y) + (a.z * a.z + a.w * a.w) + (b.x * b.x + b.y * b.y) + (b.z * b.z + b.w * b.w); }
                s += __shfl_xor(s, 16); s += __shfl_xor(s, 32);
                if (fq == 0) P[(ai * 128 + wr * 64 + m * 16 + fr) * 4 + wc] = s;
            }
        }
        asm volatile("s_waitcnt lgkmcnt(0)" ::: "memory"); __builtin_amdgcn_s_barrier(); asm volatile("" ::: "memory");
        const int row = wid * 32 + (lane & 31);
        if (lane < 32) {
            const float t = (P[row * 4 + 0] + P[row * 4 + 1]) + (P[row * 4 + 2] + P[row * 4 + 3]);
            __hip_atomic_store(xch + (size_t)(u.pm * 256 + row) * 4 + u.pn, __float_as_uint(t), __ATOMIC_RELAXED, __HIP_MEMORY_SCOPE_AGENT);
        }
        asm volatile("s_waitcnt vmcnt(0)" ::: "memory");
        if (lane == 0) __hip_atomic_fetch_add(cnt + 64 * u.pm, 1u, __ATOMIC_RELAXED, __HIP_MEMORY_SCOPE_AGENT);
        if (wid == 0) {
            unsigned sp = 0;
            while ((unsigned)__builtin_amdgcn_readfirstlane(__hip_atomic_load(cnt + 64 * u.pm, __ATOMIC_RELAXED, __HIP_MEMORY_SCOPE_AGENT)) < 32u) { __builtin_amdgcn_s_sleep(2); if (++sp > (1u << 18)) break; }
            __builtin_amdgcn_fence(__ATOMIC_ACQUIRE, "agent");
        }
        asm volatile("s_waitcnt vmcnt(0) lgkmcnt(0)" ::: "memory"); __builtin_amdgcn_s_barrier(); asm volatile("" ::: "memory");
        if (lane < 32) {
            const unsigned* sl = xch + (size_t)(u.pm * 256 + row) * 4;
            const float t0 = __uint_as_float(__hip_atomic_load(sl + 0, __ATOMIC_RELAXED, __HIP_MEMORY_SCOPE_AGENT)), t1 = __uint_as_float(__hip_atomic_load(sl + 1, __ATOMIC_RELAXED, __HIP_MEMORY_SCOPE_AGENT)),
                        t2 = __uint_as_float(__hip_atomic_load(sl + 2, __ATOMIC_RELAXED, __HIP_MEMORY_SCOPE_AGENT)), t3 = __uint_as_float(__hip_atomic_load(sl + 3, __ATOMIC_RELAXED, __HIP_MEMORY_SCOPE_AGENT));
            S[row] = rsqrtf(((t0 + t1) + (t2 + t3)) * (1.f / D) + EPS);
        }
        asm volatile("s_waitcnt vmcnt(0) lgkmcnt(0)" ::: "memory"); __builtin_amdgcn_s_barrier(); asm volatile("" ::: "memory");
        f32x4 g0[2], g1[2];
#pragma unroll
        for (int bj = 0; bj < 2; ++bj) { g0[bj] = *(const f32x4*)(gw + colb + bj * 128); g1[bj] = *(const f32x4*)(gw + colb + bj * 128 + 4); }
#pragma unroll
        for (int ai = 0; ai < 2; ++ai)
#pragma unroll
            for (int m = 0; m < 4; ++m) { const int r = ai * 128 + wr * 64 + m * 16 + fr; const float rs = S[r];
                float* op = out + (size_t)(u.pm * 256 + r) * D + colb;
#pragma unroll
                for (int bj = 0; bj < 2; ++bj) { *(f32x4*)(op + bj * 128) = acc[ai][bj][m][0] * rs * g0[bj]; *(f32x4*)(op + bj * 128 + 4) = acc[ai][bj][m][1] * rs * g1[bj]; } }
    }
};

template <bool PAIRED, class F>
__device__ __forceinline__ void gemm_fast(LAS unsigned char* lds, const bf16* A, int lda, const bf16* Bt, int M, int N, int K, const F& f, int G, int c) {
    pg8::Gemm g{A, Bt, M, N, K, lda}; pg8::StaticOrder S; S.init(M, N, G, c);
    if constexpr (PAIRED) { EpiPair<F> E{f}; pg8::gemm_phase<EpiPair<F>, pg8::StaticOrder, true, true>(lds, g, S, E); }
    else { EpiRow8<F> E{f}; pg8::gemm_phase<EpiRow8<F>, pg8::StaticOrder, true, true>(lds, g, S, E); }
}

#ifndef USE_NAIVE_GEMM
#define USE_NAIVE_GEMM 0
#endif
#if USE_NAIVE_GEMM
#define GEMM(PAIRED, A, lda, Bt, M, N, K, E) gemm_naive<PAIRED>(A, lda, Bt, M, N, K, E, gw, ngw, lane)
#else
#define GEMM(PAIRED, A, lda, Bt, M, N, K, E) gemm_fast<PAIRED>((LAS unsigned char*)lds, A, lda, Bt, NREAL, N, K, E, G, wg)
#endif

namespace attn_body {
using bf16=__hip_bfloat16;
using bf16x8=__attribute__((ext_vector_type(8)))short;
using s16x4=__attribute__((ext_vector_type(4)))short;
using f32x16=__attribute__((ext_vector_type(16)))float;
using u32x4=__attribute__((ext_vector_type(4)))unsigned;
constexpr int D=64,QP=3584,OPITCH=1024;
constexpr int NW=8,QBLK=32,QB=QBLK*NW,KVBLK=64;
__device__ __forceinline__ int crow(int r,int hi){return (r&3)+8*(r>>2)+4*hi;}
#define SBAR() __builtin_amdgcn_sched_barrier(0)
__device__ __forceinline__ void cmask(f32x16&p0,f32x16&p1,int jb,int qrel,int hi){
  const float NEG=-INFINITY; int kb=64*jb+4*hi;
  #pragma unroll
  for(int r=0;r<16;++r){int kv=kb+(r&3)+8*(r>>2); if(kv>qrel)p0[r]=NEG; if(kv+32>qrel)p1[r]=NEG;}
}

constexpr int NSLOT=3, SLOTB=8192;
constexpr int VSLOTB=2*SLOTB;
constexpr int LDS_K=0, LDS_V=NSLOT*SLOTB, LDS_WS=LDS_V+NSLOT*VSLOTB, LDS_OST=LDS_WS+NW*64*4, LDS_BYTES=LDS_OST+NW*4096;
constexpr float C2=0.125f*1.4426950408889634f;
__device__ __forceinline__ void glds16(const void*gsrc,unsigned lds_dst){unsigned keep;
  asm volatile("s_mov_b32 %0, m0\n\ts_mov_b32 m0, %2\n\ts_nop 0\n\tglobal_load_lds_dwordx4 %1, off\n\ts_mov_b32 m0, %0":"=&s"(keep):"v"(gsrc),"s"(lds_dst):"memory");}
__device__ __forceinline__ float max3f(float a,float b,float c){float r;asm("v_max3_f32 %0, %1, %2, %3":"=v"(r):"v"(a),"v"(b),"v"(c));return r;}
__device__ __forceinline__ float max2f(float a,float b){float r;asm("v_max_f32_e32 %0, %1, %2":"=v"(r):"v"(a),"v"(b));return r;}
__device__ __forceinline__ float fadd_s(float a,float b){float r;asm("v_add_f32_e32 %0, %1, %2":"=v"(r):"v"(a),"v"(b));return r;}
__device__ __forceinline__ float fsub_s(float a,float b){float r;asm("v_sub_f32_e32 %0, %1, %2":"=v"(r):"v"(a),"v"(b));return r;}
typedef float f32x2_t __attribute__((ext_vector_type(2))); typedef __bf16 bf16x2_t __attribute__((ext_vector_type(2)));
__device__ __forceinline__ unsigned cvtpk_s(float lo,float hi){f32x2_t v={lo,hi};bf16x2_t b=__builtin_convertvector(v,bf16x2_t);return __builtin_bit_cast(unsigned,b);}
#define WAIT_BAR(N) asm volatile("s_waitcnt vmcnt(" #N ") lgkmcnt(0)\n\ts_barrier":::"memory")

__device__ __forceinline__ void qkt(f32x16&p0,f32x16&p1,const char*Kslot,const bf16x8*qr,int r32,int hi){
  const char*kb=Kslot+hi*1024+r32*16;
  #pragma unroll
  for(int d0=0;d0<4;++d0){
    const bf16x8 b0=*reinterpret_cast<const bf16x8*>(kb+d0*2048);
    const bf16x8 b1=*reinterpret_cast<const bf16x8*>(kb+d0*2048+512);
    if(d0==0){p0=__builtin_amdgcn_mfma_f32_32x32x16_bf16(b0,qr[0],f32x16{},0,0,0);p1=__builtin_amdgcn_mfma_f32_32x32x16_bf16(b1,qr[0],f32x16{},0,0,0);}
    else{p0=__builtin_amdgcn_mfma_f32_32x32x16_bf16(b0,qr[d0],p0,0,0,0);p1=__builtin_amdgcn_mfma_f32_32x32x16_bf16(b1,qr[d0],p1,0,0,0);}}
}
typedef __attribute__((address_space(3))) const char* lds_cptr;
typedef short v4i16_t __attribute__((ext_vector_type(4)));
__device__ __forceinline__ void kload8(bf16x8*kf,lds_cptr kp){
  kf[0]=*(const __attribute__((address_space(3))) bf16x8*)(kp);      kf[1]=*(const __attribute__((address_space(3))) bf16x8*)(kp+512);
  kf[2]=*(const __attribute__((address_space(3))) bf16x8*)(kp+2048); kf[3]=*(const __attribute__((address_space(3))) bf16x8*)(kp+2560);
  kf[4]=*(const __attribute__((address_space(3))) bf16x8*)(kp+4096); kf[5]=*(const __attribute__((address_space(3))) bf16x8*)(kp+4608);
  kf[6]=*(const __attribute__((address_space(3))) bf16x8*)(kp+6144); kf[7]=*(const __attribute__((address_space(3))) bf16x8*)(kp+6656);
}
__device__ __forceinline__ void kload2(bf16x8*kf,lds_cptr kp,int j){ kf[2*j]=*(const __attribute__((address_space(3))) bf16x8*)(kp+j*2048); kf[2*j+1]=*(const __attribute__((address_space(3))) bf16x8*)(kp+j*2048+512); }
__device__ __forceinline__ s16x4 vtr(lds_cptr p){ return __builtin_bit_cast(s16x4,__builtin_amdgcn_ds_read_tr16_b64_v4i16((__attribute__((address_space(3))) v4i16_t*)p)); }
__device__ __forceinline__ float rowmax(const f32x16&p0,const f32x16&p1){
  float a=max3f(p0[0],p0[1],p1[0]),b=max3f(p0[2],p0[3],p1[1]);a=max3f(a,p1[2],p1[3]);
  #pragma unroll
  for(int r=4;r<16;r+=4){a=max3f(a,p0[r],p0[r+1]);b=max3f(b,p0[r+2],p0[r+3]);a=max3f(a,p1[r],p1[r+1]);b=max3f(b,p1[r+2],p1[r+3]);}
  const float m=max2f(a,b);
  auto rr=__builtin_amdgcn_permlane32_swap(__float_as_uint(m),__float_as_uint(m),false,false);
  return max2f(__uint_as_float(rr[0]),__uint_as_float(rr[1]));
}
__device__ __forceinline__ void pv(f32x16*o,int vb,bf16x8 pa0,bf16x8 pa1,bf16x8 pa2,bf16x8 pa3){
  #pragma unroll
  for(int d0=0;d0<4;++d0){s16x4 lo[4],hi[4];
    #pragma unroll
    for(int ks=0;ks<4;++ks){
      asm volatile("ds_read_b64_tr_b16 %0,%1 offset:%c2":"=&v"(lo[ks]):"v"(vb),"i"(d0*4096+ks*1024):"memory");
      asm volatile("ds_read_b64_tr_b16 %0,%1 offset:%c2":"=&v"(hi[ks]):"v"(vb),"i"(d0*4096+ks*1024+512):"memory");}
    asm volatile("s_waitcnt lgkmcnt(0)":::"memory");SBAR();
    #define PK(k) (bf16x8){lo[k][0],lo[k][1],lo[k][2],lo[k][3],hi[k][0],hi[k][1],hi[k][2],hi[k][3]}
    o[d0]=__builtin_amdgcn_mfma_f32_32x32x16_bf16(pa0,PK(0),o[d0],0,0,0);
    o[d0]=__builtin_amdgcn_mfma_f32_32x32x16_bf16(pa1,PK(1),o[d0],0,0,0);
    o[d0]=__builtin_amdgcn_mfma_f32_32x32x16_bf16(pa2,PK(2),o[d0],0,0,0);
    o[d0]=__builtin_amdgcn_mfma_f32_32x32x16_bf16(pa3,PK(3),o[d0],0,0,0);
    #undef PK
  }
}

#ifndef ATTN_STORE16
#define ATTN_STORE16(p,v) (*(u32x4*)(p)=(v))
#endif
template<int THRL> __device__ __forceinline__ void attn_unit(int qb,const bf16*Qu,const bf16*Km,const bf16*Kr,const bf16*Vr,bf16*Ou,char*shm){
  const int tid=threadIdx.x,lane=tid&63,r32=lane&31,hi=lane>>5; const int wid=__builtin_amdgcn_readfirstlane(tid>>6);
  const bf16*Qw=Qu+(long)(wid*QBLK)*QP;
  const unsigned lds0=(unsigned)(uintptr_t)shm;
  float*wsf=(float*)(shm+LDS_WS)+wid*64;
  const bf16*ksrc=Kr+(long)(lane-KVBLK)*QP+wid*8;
  const bf16*vsrc=Vr+(long)(16*(wid&3)+(lane>>2)-KVBLK)*QP+(wid>>2)*32+(lane&3)*8;
  const long off0=(long)(Km-Kr)+(long)KVBLK*QP;
  const unsigned kdst=lds0+LDS_K+wid*1024, vdst=lds0+LDS_V+wid*1024;
  #define DMA_K(t,slot) glds16(ksrc+(((t)==0)?off0:(long)(t)*KVBLK*QP),(unsigned)__builtin_amdgcn_readfirstlane(kdst+(slot)))
  #define DMA_V(t,slot) do{ const bf16*vs_=vsrc+(((t)==0)?off0:(long)(t)*KVBLK*QP); const unsigned vd_=(unsigned)__builtin_amdgcn_readfirstlane(vdst+2*(slot)); glds16(vs_,vd_); glds16(vs_+64,vd_+8192u); }while(0)
  const int vb0=(int)(lds0+LDS_V)+((lane>>4)&1)*32+(lane&3)*8+(4*hi+((lane&15)>>2))*64;
  const char*Kbase=shm+LDS_K; bf16x8 kf[8];
  const lds_cptr shm3=(lds_cptr)shm; const lds_cptr kp0=shm3+LDS_K+hi*1024+r32*16; const lds_cptr vp0=shm3+LDS_V+((lane>>4)&1)*32+(lane&3)*8+(4*hi+((lane&15)>>2))*64;
  const int NT=4*qb+5;
  DMA_K(0,0);DMA_V(0,0);DMA_K(1,SLOTB);
  bf16x8 qr[4];
  #pragma unroll
  for(int d0=0;d0<4;++d0)qr[d0]=*reinterpret_cast<const bf16x8*>(&Qw[(long)r32*QP+d0*16+hi*8]);
  float mhat=0.f,l_reg=0.f;f32x16 o[4];o[0]=f32x16{};o[1]=f32x16{};o[2]=f32x16{};o[3]=f32x16{};
  const int qrel=wid*QBLK+r32;
  #define CMASK(P0,P1,t) do{int jb_=(t)-(NT-4); if(jb_>=0)cmask(P0,P1,jb_,qrel,hi);}while(0)
  bool resc=false;
  #define START(P0,P1) do{ const float rm=rowmax(P0,P1); resc=false; mhat=rm; \
    _Pragma("unroll") for(int r=0;r<16;++r)P0[r]=__builtin_amdgcn_exp2f(P0[r]-mhat); }while(0)
  #define RESC() do{ if(resc){ asm volatile("s_waitcnt lgkmcnt(0)":::"memory"); \
      _Pragma("unroll") for(int d_=0;d_<4;++d_) _Pragma("unroll") for(int r=0;r<16;++r)o[d_][r]*=wsf[crow(r,hi)]; } }while(0)
  f32x16 pA0,pA1,pB0,pB1;
  int sl_prev=0,sl_cur=0,sl_next=SLOTB;
  #define ROT() do{sl_prev=sl_cur;sl_cur=sl_next;sl_next=(sl_next==(NSLOT-1)*SLOTB)?0:sl_next+SLOTB;}while(0)
  DMA_K(2,2*SLOTB);
  WAIT_BAR(3);
  qkt(pA0,pA1,Kbase,qr,r32,hi);asm volatile("s_nop 15\n\ts_nop 7":"+v"(pA0),"+v"(pA1));
  { _Pragma("unroll") for(int r=0;r<16;++r)pA0[r]=-INFINITY; _Pragma("unroll") for(int r=0;r<8;++r)pA1[r]=-INFINITY; }
  START(pA0,pA1);
  _Pragma("unroll") for(int r=0;r<16;++r)pA1[r]=__builtin_amdgcn_exp2f(pA1[r]-mhat);
  WAIT_BAR(0);
  DMA_K(3,0);DMA_V(1,SLOTB);
  ROT();
  kload8(kf,kp0+sl_cur);
  WAIT_BAR(3);
  s16x4 vlo[8],vhi[8]; u32x4 pw0,pw1,pw2,pw3;
  #define PKW(P,B) cvtpk_s(P[B],P[B+1])
  #define PAF(k) __builtin_bit_cast(bf16x8,pw##k)
  #define VFR(i) (bf16x8){vlo[i][0],vlo[i][1],vlo[i][2],vlo[i][3],vhi[i][0],vhi[i][1],vhi[i][2],vhi[i][3]}
  #define PIN(x) asm volatile("":"+v"(x))
  #define MX3(a,b,c) __builtin_fmaxf(__builtin_fmaxf((a),(b)),(c))
  #define GAPA(MF,A0,A1,A2,A3,W0,W1,PW) do{ MF; sacc+=A0; sacc+=A1; sacc+=A2; sacc+=A3; PIN(sacc); W0; W1; PIN(PW); SBAR(); }while(0)
  #define EX(v) __builtin_amdgcn_exp2f(v)
  #define GAPB(MF,X,B) do{ MF; { typedef float f2_ __attribute__((ext_vector_type(2))); f2_ t_={X[B],X[B+1]}; t_=t_-mhat; X[B]=EX(t_.x); X[B+1]=EX(t_.y); } PIN(X); SBAR(); }while(0)
  #define VRD2(i) do{ vlo[i]=vtr(vp_+((((i)>>2)+2)*4096+((i)&3)*1024)); vhi[i]=vtr(vp_+((((i)>>2)+2)*4096+((i)&3)*1024+512)); SBAR(); }while(0)
  #define VRD(i) do{ vlo[i]=vtr(vp_+(((i)>>2)*4096+((i)&3)*1024)); vhi[i]=vtr(vp_+(((i)>>2)*4096+((i)&3)*1024+512)); }while(0)
  #define KRD(G,j) do{ if(G){ kload2(kf,kp0+sl_next,j); SBAR(); } }while(0)
  #define STEP(C0,C1,P0,P1,t,GK,GV,GL) do{ SBAR(); \
    const lds_cptr vp_=vp0+2*sl_prev; \
    VRD(0); SBAR(); float sacc=(P0[0]+P0[1]); \
    GAPA(C0=__builtin_amdgcn_mfma_f32_32x32x16_bf16(kf[0],qr[0],f32x16{},0,0,0), P0[2],P0[3],P0[4],P0[5],     pw0[0]=PKW(P0,0), pw0[1]=PKW(P0,2), pw0); \
    VRD(4); SBAR(); GAPA(C1=__builtin_amdgcn_mfma_f32_32x32x16_bf16(kf[1],qr[0],f32x16{},0,0,0), P0[6],P0[7],P0[8],P0[9],     pw0[2]=PKW(P0,4), pw0[3]=PKW(P0,6), pw0); \
    VRD(1); SBAR(); GAPA(C0=__builtin_amdgcn_mfma_f32_32x32x16_bf16(kf[2],qr[1],C0,0,0,0),   P0[10],P0[11],P0[12],P0[13], pw1[0]=PKW(P0,8), pw1[1]=PKW(P0,10), pw1); \
    VRD(5); SBAR(); GAPA(C1=__builtin_amdgcn_mfma_f32_32x32x16_bf16(kf[3],qr[1],C1,0,0,0),   P0[14],P0[15],P1[0],P1[1],   pw1[2]=PKW(P0,12),pw1[3]=PKW(P0,14), pw1); \
    VRD(2); SBAR(); GAPA(C0=__builtin_amdgcn_mfma_f32_32x32x16_bf16(kf[4],qr[2],C0,0,0,0),   P1[2],P1[3],P1[4],P1[5],     pw2[0]=PKW(P1,0), pw2[1]=PKW(P1,2), pw2); \
    VRD(6); SBAR(); GAPA(C1=__builtin_amdgcn_mfma_f32_32x32x16_bf16(kf[5],qr[2],C1,0,0,0),   P1[6],P1[7],P1[8],P1[9],     pw2[2]=PKW(P1,4), pw2[3]=PKW(P1,6), pw2); \
    VRD(3); SBAR(); GAPA(C0=__builtin_amdgcn_mfma_f32_32x32x16_bf16(kf[6],qr[3],C0,0,0,0),   P1[10],P1[11],P1[12],P1[13], pw3[0]=PKW(P1,8), pw3[1]=PKW(P1,10), pw3); \
    VRD(7); SBAR(); GAPA(C1=__builtin_amdgcn_mfma_f32_32x32x16_bf16(kf[7],qr[3],C1,0,0,0),   P1[14],P1[15],0.f,0.f,       pw3[2]=PKW(P1,12),pw3[3]=PKW(P1,14), pw3); \
    l_reg+=sacc; \
    if(GK){DMA_K((t)+3,sl_cur);} if(GV){DMA_V((t)+1,sl_next);} \
    CMASK(C0,C1,t); \
    { float a=MX3(C0[0],C0[1],C1[0]),b=MX3(C0[2],C0[3],C1[1]); a=MX3(a,C1[2],C1[3]); \
      _Pragma("unroll") for(int r=4;r<16;r+=4){a=MX3(a,C0[r],C0[r+1]);b=MX3(b,C0[r+2],C0[r+3]);a=MX3(a,C1[r],C1[r+1]);b=MX3(b,C1[r+2],C1[r+3]);} \
      float rm=__builtin_fmaxf(a,b); { auto rr=__builtin_amdgcn_permlane32_swap(__float_as_uint(rm),__float_as_uint(rm),false,false); rm=__builtin_fmaxf(__uint_as_float(rr[0]),__uint_as_float(rr[1])); } \
      resc=false; \
      const float rmr=rm-mhat;                                         \
      if(__builtin_expect(__any(rmr>(float)THRL),0)){ const float dl=__builtin_fmaxf(rmr,0.f); mhat+=dl; \
        const float f=__builtin_amdgcn_exp2f(-dl); l_reg*=f; if(hi==0)wsf[r32]=f; resc=true; } } \
    SBAR(); \
    GAPB(o[0]=__builtin_amdgcn_mfma_f32_32x32x16_bf16(PAF(0),VFR(0),o[0],0,0,0), C0,0); VRD2(0); \
    GAPB(o[1]=__builtin_amdgcn_mfma_f32_32x32x16_bf16(PAF(0),VFR(4),o[1],0,0,0), C0,2); VRD2(4); \
    GAPB(o[0]=__builtin_amdgcn_mfma_f32_32x32x16_bf16(PAF(1),VFR(1),o[0],0,0,0), C0,4); VRD2(1); \
    GAPB(o[1]=__builtin_amdgcn_mfma_f32_32x32x16_bf16(PAF(1),VFR(5),o[1],0,0,0), C0,6); VRD2(5); \
    GAPB(o[0]=__builtin_amdgcn_mfma_f32_32x32x16_bf16(PAF(2),VFR(2),o[0],0,0,0), C0,8); VRD2(2); \
    GAPB(o[1]=__builtin_amdgcn_mfma_f32_32x32x16_bf16(PAF(2),VFR(6),o[1],0,0,0), C0,10); VRD2(6); \
    GAPB(o[0]=__builtin_amdgcn_mfma_f32_32x32x16_bf16(PAF(3),VFR(3),o[0],0,0,0), C0,12); VRD2(3); \
    GAPB(o[1]=__builtin_amdgcn_mfma_f32_32x32x16_bf16(PAF(3),VFR(7),o[1],0,0,0), C0,14); VRD2(7); \
    GAPB(o[2]=__builtin_amdgcn_mfma_f32_32x32x16_bf16(PAF(0),VFR(0),o[2],0,0,0), C1,0); \
    GAPB(o[3]=__builtin_amdgcn_mfma_f32_32x32x16_bf16(PAF(0),VFR(4),o[3],0,0,0), C1,2); \
    KRD(GL,0); GAPB(o[2]=__builtin_amdgcn_mfma_f32_32x32x16_bf16(PAF(1),VFR(1),o[2],0,0,0), C1,4); \
    KRD(GL,1); GAPB(o[3]=__builtin_amdgcn_mfma_f32_32x32x16_bf16(PAF(1),VFR(5),o[3],0,0,0), C1,6); \
    KRD(GL,2); GAPB(o[2]=__builtin_amdgcn_mfma_f32_32x32x16_bf16(PAF(2),VFR(2),o[2],0,0,0), C1,8); \
    KRD(GL,3); GAPB(o[3]=__builtin_amdgcn_mfma_f32_32x32x16_bf16(PAF(2),VFR(6),o[3],0,0,0), C1,10); \
    GAPB(o[2]=__builtin_amdgcn_mfma_f32_32x32x16_bf16(PAF(3),VFR(3),o[2],0,0,0), C1,12); \
    GAPB(o[3]=__builtin_amdgcn_mfma_f32_32x32x16_bf16(PAF(3),VFR(7),o[3],0,0,0), C1,14); \
    }while(0)
  int t=1;
  #undef CMASK
  #define CMASK(P0,P1,t) do{}while(0)
  for(;t+5<NT;t+=2){
    STEP(pB0,pB1,pA0,pA1,t,true,true,true);     WAIT_BAR(3); RESC(); ROT();
    STEP(pA0,pA1,pB0,pB1,t+1,true,true,true);   WAIT_BAR(3); RESC(); ROT();
  }
  #undef CMASK
  #define CMASK(P0,P1,t) do{int jb_=(t)-(NT-4); if(jb_>=0)cmask(P0,P1,jb_,qrel,hi);}while(0)
  #define ENDW(tt) do{ if((tt)+3<NT){WAIT_BAR(3);} else if((tt)+2<NT){WAIT_BAR(2);} else {WAIT_BAR(0);} }while(0)
  for(;t+1<NT;t+=2){
    STEP(pB0,pB1,pA0,pA1,t,(t+3<NT),(t+1<NT),(t+1<NT));       ENDW(t);   RESC(); ROT();
    STEP(pA0,pA1,pB0,pB1,t+1,(t+4<NT),(t+2<NT),(t+2<NT));     ENDW(t+1); RESC(); ROT();
  }
  { float sacc=pA0[0]+pA0[1]; _Pragma("unroll") for(int r=2;r<16;++r)sacc+=pA0[r]; _Pragma("unroll") for(int r=0;r<16;++r)sacc+=pA1[r]; l_reg+=sacc;
    pw0=(u32x4){PKW(pA0,0),PKW(pA0,2),PKW(pA0,4),PKW(pA0,6)};pw1=(u32x4){PKW(pA0,8),PKW(pA0,10),PKW(pA0,12),PKW(pA0,14)};pw2=(u32x4){PKW(pA1,0),PKW(pA1,2),PKW(pA1,4),PKW(pA1,6)};pw3=(u32x4){PKW(pA1,8),PKW(pA1,10),PKW(pA1,12),PKW(pA1,14)};
    SBAR(); pv(o,vb0+2*sl_prev,PAF(0),PAF(1),PAF(2),PAF(3)); }
  #undef PKW
  #undef PAF
  #undef VFR
  #undef PIN
  #undef MX3
  #undef GAPA
  #undef GAPB
  #undef EX
  #undef VRD
  #undef VRD2
  #undef KRD
  #undef STEP
  #undef ENDW
  {auto rr=__builtin_amdgcn_permlane32_swap(__float_as_uint(l_reg),__float_as_uint(l_reg),false,false);l_reg=__uint_as_float(rr[0])+__uint_as_float(rr[1]);}
  if(hi==0)wsf[32+r32]=l_reg;asm volatile("s_waitcnt lgkmcnt(0)":::"memory");
  float rli[16];
  #pragma unroll
  for(int r=0;r<16;++r)rli[r]=__builtin_amdgcn_rcpf(wsf[32+crow(r,hi)]);
  bf16*Ow=Ou+(long)(wid*QBLK)*OPITCH;
  { bf16*stg=(bf16*)(shm+LDS_OST)+wid*2048;
    #pragma unroll
    for(int dh=0;dh<2;++dh){
      #pragma unroll
      for(int r=0;r<16;++r){const int orow=crow(r,hi);
        #pragma unroll
        for(int d0=0;d0<2;++d0)stg[orow*64+d0*32+r32]=__float2bfloat16(o[2*dh+d0][r]*rli[r]);}
      asm volatile("s_waitcnt lgkmcnt(0)":::"memory");
      #pragma unroll
      for(int i=0;i<4;++i){const int row=i*8+(lane>>3),ch=lane&7; const u32x4 v=*(const u32x4*)(stg+row*64+ch*8); ATTN_STORE16(Ow+(long)row*OPITCH+dh*64+ch*8,v);}
      asm volatile("s_waitcnt lgkmcnt(0)":::"memory"); } }
  asm volatile("s_waitcnt lgkmcnt(0)\n\ts_barrier":::"memory");
  #undef DMA_K
  #undef DMA_V
  #undef CMASK
  #undef START
  #undef RESC
  #undef ROT
}
constexpr int ATTN_LDS_BYTES=LDS_BYTES;
#undef SBAR
#undef WAIT_BAR
}

__device__ __forceinline__ void stage_attn_fast(const Params& p, char* lds, int vcu, int G) {
    typedef attn_body::bf16 abf;
    const abf* proj = (const abf*)(p.ws + WS_PROJ); abf* OP = (abf*)(p.ws + WS_OP);
    for (int g = vcu; g < 256; g += G) {
        const int hh = g >> 2, s = g & 3, b = hh >> 3, h = (hh >> 1) & 3, m = hh & 1;
#pragma unroll 1
        for (int i = 0; i < 2; ++i) {
            const int qb = (i == 0) ? 7 - s : s;
            const size_t qrow = (size_t)b * SEQ + (size_t)qb * 256;
            attn_body::attn_unit<8>(qb, proj + qrow * DIN + SEG_DQ + h * 128 + m * 64,
                                    proj + (size_t)NREAL * DIN + SEG_DK + h * 128 + m * 64, proj + (size_t)b * SEQ * DIN + SEG_DK + h * 128 + m * 64,
                                    proj + (size_t)b * SEQ * DIN + SEG_DV + h * 128,
                                    OP + qrow * D + h * 256 + m * 128, lds);
        }
    }
}

constexpr int RET_RS = 272, RET_TS = 288;
constexpr int RET_K = 0, RET_V = 128 * RET_TS, RET_R = RET_V + 128 * RET_TS;
__device__ __forceinline__ int chunk_row(int b, int n, int j) { return n > 0 ? b * SEQ + 128 * (n - 1) + j : (j >= 112 ? MROW0 + j - 112 : -1); }
struct RetMat { u32x4 v[4]; };
__device__ __forceinline__ void ret_load_rows(RetMat& m, const bf16* src_col, int b, int n, int tid) {
#pragma unroll
    for (int k = 0; k < 4; ++k) { const int it = tid + 512 * k, j = it >> 4, ch = it & 15, r = chunk_row(b, n, j);
        m.v[k] = (u32x4){0u, 0u, 0u, 0u}; if (r >= 0) m.v[k] = *(const u32x4*)(src_col + (size_t)r * DIN + ch * 8); }
}
template <int ST> __device__ __forceinline__ void ret_put_rows(LAS unsigned char* dst, const RetMat& m, int tid) {
#pragma unroll
    for (int k = 0; k < 4; ++k) { const int it = tid + 512 * k, j = it >> 4, ch = it & 15; *(LAS u32x4*)(dst + j * ST + ch * 16) = m.v[k]; }
}
typedef short v4i16_t __attribute__((ext_vector_type(4)));
__device__ __forceinline__ bf16x8 ret_frag_tr(LAS unsigned char* m, int s, int cb, int lane) {
    LAS unsigned char* a = m + (32 * s + 4 * (lane >> 4) + ((lane & 15) >> 2)) * RET_TS + (16 * cb + 4 * (lane & 3)) * 2;
    const v4i16_t lo = __builtin_amdgcn_ds_read_tr16_b64_v4i16((LAS v4i16_t*)a), hi = __builtin_amdgcn_ds_read_tr16_b64_v4i16((LAS v4i16_t*)(a + 16 * RET_TS));
    return (bf16x8){lo[0], lo[1], lo[2], lo[3], hi[0], hi[1], hi[2], hi[3]};
}
__device__ __forceinline__ void stage_ret_scan(const Params& p, int gtid, int ngt) {
    const bf16* TT = (const bf16*)p.out; bf16* RP = (bf16*)(p.ws + WS_RP);
    for (int e = gtid; e < 32 * 4096; e += ngt) {
        const int bh = e >> 12, idx = e & 4095, h = bh & 3; const float g128 = exp2f(128.f * log2gamma(h));
        u32x2 tw[16];
#pragma unroll
        for (int n = 0; n < 16; ++n) tw[n] = *(const u32x2*)(TT + ((size_t)((n == 0 ? h : bh) * 16 + n) * 4096 + idx) * 4);
        f32x4 R = (f32x4){0.f, 0.f, 0.f, 0.f};
#pragma unroll
        for (int n = 0; n < 16; ++n) { const f32x4 t = (f32x4){bflo(tw[n].x), bfhi(tw[n].x), bflo(tw[n].y), bfhi(tw[n].y)}; R = (R + t) * g128;
            u32x2 wv; wv.x = pk2(R.x, R.y); wv.y = pk2(R.z, R.w); *(u32x2*)(RP + ((size_t)(bh * 16 + n) * 4096 + idx) * 4) = wv; }
    }
}
__device__ __forceinline__ void ret_state_ids(int u, int& bh, int& n) { if (u < 480) { bh = u / 15; n = 1 + u % 15; } else { bh = u - 480; n = 0; } }
__device__ __forceinline__ void ret_state_load(const Params& p, int u, int tid, RetMat& k, RetMat& v) {
    int bh, n; ret_state_ids(u, bh, n); const int b = bh >> 2, h = bh & 3;
    const bf16* proj = (const bf16*)(p.ws + WS_PROJ);
    ret_load_rows(k, proj + SEG_RK + h * 128, b, n, tid); ret_load_rows(v, proj + SEG_RV + h * 128, b, n, tid);
}
__device__ __forceinline__ void ret_state_compute(const Params& p, LAS unsigned char* lds, int u, int tid) {
    int bh, n; ret_state_ids(u, bh, n);
    bf16* TT = (bf16*)p.out + (size_t)(bh * 16 + n) * 16384;
    const int lane = tid & 63, w = tid >> 6, i = lane & 15, g = lane >> 4;
    f32x4 acc[8];
#pragma unroll
    for (int nf = 0; nf < 8; ++nf) acc[nf] = (f32x4){0.f, 0.f, 0.f, 0.f};
#pragma unroll
    for (int s = 0; s < 4; ++s) {
        const bf16x8 a = ret_frag_tr(lds + RET_V, s, w, lane);
#pragma unroll
        for (int nf = 0; nf < 8; ++nf) { const bf16x8 bb = ret_frag_tr(lds + RET_K, s, nf, lane);
            acc[nf] = __builtin_amdgcn_mfma_f32_16x16x32_bf16(bb, a, acc[nf], 0, 0, 0); }
    }
#pragma unroll
    for (int nf = 0; nf < 8; ++nf) { u32x2 wv; wv.x = pk2(acc[nf][0], acc[nf][1]); wv.y = pk2(acc[nf][2], acc[nf][3]); *(u32x2*)(TT + (16 * w + i) * 128 + 16 * nf + 4 * g) = wv; }
}
__device__ __forceinline__ void stage_ret_states(const Params& p, LAS unsigned char* lds, int first, int stride, int tid) {
    int u = first; if (u >= 484) return;
    RetMat k, v; ret_state_load(p, u, tid, k, v);
    for (;;) {
        ret_put_rows<RET_TS>(lds + RET_K, k, tid); ret_put_rows<RET_TS>(lds + RET_V, v, tid);
        __syncthreads();
        const int un = u + stride; const bool more = un < 484;
        if (more) ret_state_load(p, un, tid, k, v);
        ret_state_compute(p, lds, u, tid);
        __syncthreads();
        if (!more) break;
        u = un;
    }
}
struct RetOutRegs { RetMat k, v, r; };
__device__ __forceinline__ void ret_out_ids(int u, int& bh, int& c) { if (u < 512) { bh = u >> 4; c = 1 + (u & 15); } else { bh = u - 512; c = 0; } }
__device__ __forceinline__ void ret_out_load(const Params& p, int u, int tid, RetOutRegs& R) {
    int bh, c; ret_out_ids(u, bh, c); const int b = bh >> 2, h = bh & 3;
    const bf16* proj = (const bf16*)(p.ws + WS_PROJ); const bf16* RP = (const bf16*)(p.ws + WS_RP) + (size_t)(bh * 16 + (c > 0 ? c - 1 : 0)) * 16384;
    ret_load_rows(R.k, proj + SEG_RK + h * 128, b, c, tid); ret_load_rows(R.v, proj + SEG_RV + h * 128, b, c, tid);
#pragma unroll
    for (int k = 0; k < 4; ++k) { const int it = tid + 512 * k, j = it >> 4, ch = it & 15; R.r.v[k] = *(const u32x4*)(RP + j * 128 + ch * 8); }
}
__device__ __forceinline__ void ret_out_put(LAS unsigned char* lds, const RetOutRegs& R, int tid) {
    ret_put_rows<RET_RS>(lds + RET_K, R.k, tid); ret_put_rows<RET_TS>(lds + RET_V, R.v, tid); ret_put_rows<RET_RS>(lds + RET_R, R.r, tid);
}
__device__ __forceinline__ void ret_out_qload(const Params& p, int u, int tid, bf16x8 (&qf)[4]) {
    int bh, c; ret_out_ids(u, bh, c); const int b = bh >> 2, h = bh & 3;
    const bf16* proj = (const bf16*)(p.ws + WS_PROJ);
    const int lane = tid & 63, w = tid >> 6, i = lane & 15, g = lane >> 4;
    const int qrow = chunk_row(b, c, 16 * w + i), qr = qrow >= 0 ? qrow : MROW0;
#pragma unroll
    for (int s = 0; s < 4; ++s) qf[s] = *(const bf16x8*)(proj + (size_t)qr * DIN + SEG_RQ + h * 128 + 32 * s + 8 * g);
}
__device__ __forceinline__ void ret_out_compute(const Params& p, LAS unsigned char* lds, int u, int tid, const bf16x8 (&qfin)[4]) {
    int bh, c; ret_out_ids(u, bh, c); const int b = bh >> 2, h = bh & 3;
    bf16* proj = (bf16*)(p.ws + WS_PROJ);
    const int lane = tid & 63, w = tid >> 6, i = lane & 15, g = lane >> 4;
    const int q = 16 * w + i, qrow = chunk_row(b, c, q);
    bf16x8 qf[4];
#pragma unroll
    for (int s = 0; s < 4; ++s) qf[s] = qrow >= 0 ? qfin[s] : (bf16x8){0, 0, 0, 0, 0, 0, 0, 0};
    f32x4 st[8];
#pragma unroll
    for (int mf = 0; mf < 8; ++mf) {
        st[mf] = (f32x4){0.f, 0.f, 0.f, 0.f};
        if (mf <= w) {
#pragma unroll
            for (int s = 0; s < 4; ++s) { const bf16x8 a = *(const LAS bf16x8*)(lds + RET_K + (16 * mf + i) * RET_RS + (32 * s + 8 * g) * 2);
                st[mf] = __builtin_amdgcn_mfma_f32_16x16x32_bf16(a, qf[s], st[mf], 0, 0, 0); }
#pragma unroll
            for (int r = 0; r < 4; ++r) if (16 * mf + 4 * g + r > q) st[mf][r] = 0.f;
        }
    }
    bf16x8 pf[4];
#pragma unroll
    for (int s = 0; s < 4; ++s) { const u32x4 wv = (u32x4){pk2(st[2 * s][0], st[2 * s][1]), pk2(st[2 * s][2], st[2 * s][3]), pk2(st[2 * s + 1][0], st[2 * s + 1][1]), pk2(st[2 * s + 1][2], st[2 * s + 1][3])};
        pf[s] = __builtin_bit_cast(bf16x8, wv); }
    u32x2 gv[8];
    { const bf16* gq = proj + (size_t)(qrow >= 0 ? qrow : MROW0) * DIN + SEG_RG + h * 128 + 4 * g;
#pragma unroll
      for (int mf = 0; mf < 8; ++mf) gv[mf] = *(const u32x2*)(gq + 16 * mf); }
    f32x4 o[8];
#pragma unroll
    for (int mf = 0; mf < 8; ++mf) {
        o[mf] = (f32x4){0.f, 0.f, 0.f, 0.f};
#pragma unroll
        for (int s = 0; s < 4; ++s) {
            if (2 * s <= w) {
                o[mf] = __builtin_amdgcn_mfma_f32_16x16x32_bf16(ret_frag_tr(lds + RET_V, s, mf, lane), pf[s], o[mf], 0, 0, 0);
            }
        }
        if (c > 0) {
#pragma unroll
            for (int s = 0; s < 4; ++s) { const bf16x8 a = *(const LAS bf16x8*)(lds + RET_R + (16 * mf + i) * RET_RS + (32 * s + 8 * g) * 2);
                o[mf] = __builtin_amdgcn_mfma_f32_16x16x32_bf16(a, qf[s], o[mf], 0, 0, 0); }
        }
    }
    float sm = 0.f;
#pragma unroll
    for (int mf = 0; mf < 8; ++mf) sm += (o[mf][0] + o[mf][1]) + (o[mf][2] + o[mf][3]);
    sm += __shfl_xor(sm, 16); sm += __shfl_xor(sm, 32);
    const float mu = sm * (1.f / 128.f);
    float vr = 0.f;
#pragma unroll
    for (int mf = 0; mf < 8; ++mf) { o[mf] = o[mf] - mu; vr += (o[mf][0] * o[mf][0] + o[mf][1] * o[mf][1]) + (o[mf][2] * o[mf][2] + o[mf][3] * o[mf][3]); }
    vr += __shfl_xor(vr, 16); vr += __shfl_xor(vr, 32);
    const float rs = rsqrtf(vr * (1.f / 128.f) + EPS);
    if (qrow >= 0) {
        bf16* gp = proj + (size_t)qrow * DIN + SEG_RG + h * 128 + 4 * g;
#pragma unroll
        for (int mf = 0; mf < 8; ++mf) { u32x2 wv;
            wv.x = pk2(bflo(gv[mf].x) * o[mf][0] * rs, bfhi(gv[mf].x) * o[mf][1] * rs); wv.y = pk2(bflo(gv[mf].y) * o[mf][2] * rs, bfhi(gv[mf].y) * o[mf][3] * rs);
            *(u32x2*)(gp + 16 * mf) = wv; }
    }
}
__device__ __forceinline__ void stage_ret_outs(const Params& p, LAS unsigned char* lds, int first, int stride, int end, int tid) {
    int u = first; if (u >= end) return;
    RetOutRegs R; ret_out_load(p, u, tid, R);
    for (;;) {
        bf16x8 qf[4]; ret_out_qload(p, u, tid, qf);
        ret_out_put(lds, R, tid);
        __syncthreads();
        const int un = u + stride; const bool more = un < end;
        if (more) ret_out_load(p, un, tid, R);
        ret_out_compute(p, lds, u, tid, qf);
        __syncthreads();
        if (!more) break;
        u = un;
    }
}

__device__ __forceinline__ void attn_key(const float (&q)[64], const bf16* krow, const bf16* vrow, float& m, float& l, float (&o)[64]) {
    float s = 0.f;
#pragma unroll
    for (int c = 0; c < 8; ++c) {
        const u32x4 kk = *(const u32x4*)(krow + 8 * c);
        s += q[8 * c] * bflo(kk.x) + q[8 * c + 1] * bfhi(kk.x) + q[8 * c + 2] * bflo(kk.y) + q[8 * c + 3] * bfhi(kk.y)
           + q[8 * c + 4] * bflo(kk.z) + q[8 * c + 5] * bfhi(kk.z) + q[8 * c + 6] * bflo(kk.w) + q[8 * c + 7] * bfhi(kk.w);
    }
    const float mn = fmaxf(m, s), f = exp2f(m - mn), pp = exp2f(s - mn);
    m = mn; l = l * f + pp;
#pragma unroll
    for (int c = 0; c < 8; ++c) {
        const u32x4 vv = *(const u32x4*)(vrow + 8 * c);
        o[8 * c] = o[8 * c] * f + pp * bflo(vv.x); o[8 * c + 1] = o[8 * c + 1] * f + pp * bfhi(vv.x);
        o[8 * c + 2] = o[8 * c + 2] * f + pp * bflo(vv.y); o[8 * c + 3] = o[8 * c + 3] * f + pp * bfhi(vv.y);
        o[8 * c + 4] = o[8 * c + 4] * f + pp * bflo(vv.z); o[8 * c + 5] = o[8 * c + 5] * f + pp * bfhi(vv.z);
        o[8 * c + 6] = o[8 * c + 6] * f + pp * bflo(vv.w); o[8 * c + 7] = o[8 * c + 7] * f + pp * bfhi(vv.w);
    }
}
__device__ __forceinline__ void stage_attn_naive(const Params& p, int first, int wg, int nwg, int tid) {
    int vz; asm volatile("v_mov_b32 %0, 0" : "=v"(vz));
    const bf16* proj = (const bf16*)(p.ws + WS_PROJ) + vz; bf16* OP = (bf16*)(p.ws + WS_OP);
    for (int it = first + wg; it < 513; it += nwg) {
        int row, h, m, vh, b = 0, nreal, nmeta;
        if (it < 512) { b = it >> 6; h = (it >> 4) & 3; m = (it >> 3) & 1; vh = (it >> 2) & 1; const int t = (it & 3) * 512 + tid; row = b * SEQ + t; nreal = t + 1; nmeta = NMETA; }
        else { if (tid >= 256) continue; h = tid >> 6; m = (tid >> 5) & 1; vh = (tid >> 4) & 1; const int i = tid & 15; row = MROW0 + i; nreal = 0; nmeta = i + 1; }
        float q[64], o[64];
        const bf16* qp = proj + (size_t)row * DIN + SEG_DQ + h * 128 + m * 64;
#pragma unroll
        for (int c = 0; c < 8; ++c) { const u32x4 v = *(const u32x4*)(qp + 8 * c);
            q[8 * c] = bflo(v.x); q[8 * c + 1] = bfhi(v.x); q[8 * c + 2] = bflo(v.y); q[8 * c + 3] = bfhi(v.y); q[8 * c + 4] = bflo(v.z); q[8 * c + 5] = bfhi(v.z); q[8 * c + 6] = bflo(v.w); q[8 * c + 7] = bfhi(v.w); }
#pragma unroll
        for (int c = 0; c < 64; ++c) o[c] = 0.f;
        float mx = -1e30f, l = 0.f;
        const size_t koff = SEG_DK + h * 128 + m * 64, voff = SEG_DV + h * 128 + vh * 64;
        for (int j = 0; j < NMETA; ++j) if (j < nmeta) attn_key(q, proj + (size_t)(MROW0 + j) * DIN + koff, proj + (size_t)(MROW0 + j) * DIN + voff, mx, l, o);
        if (it < 512) {
            const int tmax = (it & 3) * 512 + 511;
            for (int j = 0; j <= tmax; ++j) if (j < nreal) attn_key(q, proj + (size_t)(b * SEQ + j) * DIN + koff, proj + (size_t)(b * SEQ + j) * DIN + voff, mx, l, o);
        }
        const float il = 1.f / l;
        bf16* op = OP + (size_t)row * D + h * 256 + m * 128 + vh * 64;
#pragma unroll
        for (int c = 0; c < 8; ++c) { u32x4 w; w.x = pk2(o[8 * c] * il, o[8 * c + 1] * il); w.y = pk2(o[8 * c + 2] * il, o[8 * c + 3] * il);
            w.z = pk2(o[8 * c + 4] * il, o[8 * c + 5] * il); w.w = pk2(o[8 * c + 6] * il, o[8 * c + 7] * il); *(u32x4*)(op + 8 * c) = w; }
    }
}
__device__ __forceinline__ void ret_key(const unsigned (&q)[64], const bf16* krow, const bf16* vrow, float cf, float (&o)[64]) {
    float s = 0.f;
#pragma unroll
    for (int c = 0; c < 16; ++c) {
        const u32x4 kk = *(const u32x4*)(krow + 8 * c);
        s += bflo(q[4 * c]) * bflo(kk.x) + bfhi(q[4 * c]) * bfhi(kk.x) + bflo(q[4 * c + 1]) * bflo(kk.y) + bfhi(q[4 * c + 1]) * bfhi(kk.y)
           + bflo(q[4 * c + 2]) * bflo(kk.z) + bfhi(q[4 * c + 2]) * bfhi(kk.z) + bflo(q[4 * c + 3]) * bflo(kk.w) + bfhi(q[4 * c + 3]) * bfhi(kk.w);
    }
    s *= cf;
#pragma unroll
    for (int c = 0; c < 8; ++c) {
        const u32x4 vv = *(const u32x4*)(vrow + 8 * c);
        o[8 * c] += s * bflo(vv.x); o[8 * c + 1] += s * bfhi(vv.x); o[8 * c + 2] += s * bflo(vv.y); o[8 * c + 3] += s * bfhi(vv.y);
        o[8 * c + 4] += s * bflo(vv.z); o[8 * c + 5] += s * bfhi(vv.z); o[8 * c + 6] += s * bflo(vv.w); o[8 * c + 7] += s * bfhi(vv.w);
    }
}
__device__ __forceinline__ void stage_ret_naive(const Params& p, int wg, int nwg, int tid) {
    int vz; asm volatile("v_mov_b32 %0, 0" : "=v"(vz));
    const bf16* proj = (const bf16*)(p.ws + WS_PROJ) + vz; float* RT = p.out;
    for (int it = wg; it < 257; it += nwg) {
        int row, h, vh, b = 0, nreal, nmeta, nq;
        if (it < 256) { b = it >> 5; h = (it >> 3) & 3; vh = (it >> 2) & 1; const int t = (it & 3) * 512 + tid; row = b * SEQ + t; nreal = t + 1; nmeta = NMETA; nq = 1 + (t >> 7); }
        else { if (tid >= 128) continue; h = tid >> 5; vh = (tid >> 4) & 1; const int i = tid & 15; row = MROW0 + i; nreal = 0; nmeta = i + 1; nq = 0; }
        unsigned q[64]; float o[64];
        const bf16* qp = proj + (size_t)row * DIN + SEG_RQ + h * 128;
#pragma unroll
        for (int c = 0; c < 16; ++c) { const u32x4 v = *(const u32x4*)(qp + 8 * c); q[4 * c] = v.x; q[4 * c + 1] = v.y; q[4 * c + 2] = v.z; q[4 * c + 3] = v.w; }
#pragma unroll
        for (int c = 0; c < 64; ++c) o[c] = 0.f;
        const size_t koff = SEG_RK + h * 128, voff = SEG_RV + h * 128 + vh * 64;
        const float lg128 = 128.f * log2gamma(h);
        { const float cf = exp2f(lg128 * (float)nq);
          for (int j = 0; j < NMETA; ++j) if (j < nmeta) ret_key(q, proj + (size_t)(MROW0 + j) * DIN + koff, proj + (size_t)(MROW0 + j) * DIN + voff, cf, o); }
        if (it < 256) {
            const int tmax = (it & 3) * 512 + 511;
            for (int j = 0; j <= tmax; ++j) if (j < nreal) { const float cf = exp2f(lg128 * (float)(nq - 1 - (j >> 7)));
                ret_key(q, proj + (size_t)(b * SEQ + j) * DIN + koff, proj + (size_t)(b * SEQ + j) * DIN + voff, cf, o); }
        }
        float* op = RT + (size_t)row * 512 + h * 128 + vh * 64;
#pragma unroll
        for (int c = 0; c < 16; ++c) *(f32x4*)(op + 4 * c) = (f32x4){o[4 * c], o[4 * c + 1], o[4 * c + 2], o[4 * c + 3]};
    }
}
__device__ __forceinline__ void stage_retnorm(const Params& p, int gw, int ngw, int lane) {
    const float* RT = (const float*)p.out; bf16* proj = (bf16*)(p.ws + WS_PROJ);
    for (int r = gw; r < NREAL + NMETA; r += ngw) {
        const int row = r < NREAL ? r : MROW0 + (r - NREAL);
        const int h = lane >> 4, c0 = (lane & 15) * 8;
        const f32x4 a = *(const f32x4*)(RT + (size_t)row * 512 + h * 128 + c0), b = *(const f32x4*)(RT + (size_t)row * 512 + h * 128 + c0 + 4);
        float o[8] = {a.x, a.y, a.z, a.w, b.x, b.y, b.z, b.w};
        float s = 0.f;
#pragma unroll
        for (int j = 0; j < 8; ++j) s += o[j];
        s += __shfl_xor(s, 1); s += __shfl_xor(s, 2); s += __shfl_xor(s, 4); s += __shfl_xor(s, 8);
        const float mu = s * (1.f / 128.f);
        float v = 0.f;
#pragma unroll
        for (int j = 0; j < 8; ++j) { o[j] -= mu; v += o[j] * o[j]; }
        v += __shfl_xor(v, 1); v += __shfl_xor(v, 2); v += __shfl_xor(v, 4); v += __shfl_xor(v, 8);
        const float rs = rsqrtf(v * (1.f / 128.f) + EPS);
        bf16* gp = proj + (size_t)row * DIN + SEG_RG + h * 128 + c0;
        const u32x4 g = *(const u32x4*)gp; u32x4 w;
        w.x = pk2(bflo(g.x) * o[0] * rs, bfhi(g.x) * o[1] * rs); w.y = pk2(bflo(g.y) * o[2] * rs, bfhi(g.y) * o[3] * rs);
        w.z = pk2(bflo(g.z) * o[4] * rs, bfhi(g.z) * o[5] * rs); w.w = pk2(bflo(g.w) * o[6] * rs, bfhi(g.w) * o[7] * rs);
        *(u32x4*)gp = w;
    }
}
__device__ __forceinline__ void stage_combine(const Params& p, int l, int gw, int ngw, int lane) {
    const bf16* OP = (const bf16*)(p.ws + WS_OP); bf16* proj = (bf16*)(p.ws + WS_PROJ);
    const float lam = ((const float*)(p.ws + WS_TAB + TAB_LAM))[l];
    const int h = lane >> 4, c0 = (lane & 15) * 8;
    constexpr int NR = NREAL + NMETA, U = 4;
    for (int r0 = gw; r0 < NR; r0 += ngw * U) {
        u32x4 a[U], b[U]; int row[U];
#pragma unroll
        for (int k = 0; k < U; ++k) { const int r = r0 + k * ngw, rr = r < NR ? r : gw; row[k] = rr < NREAL ? rr : MROW0 + (rr - NREAL);
            a[k] = *(const u32x4*)(OP + (size_t)row[k] * D + h * 256 + c0); b[k] = *(const u32x4*)(OP + (size_t)row[k] * D + h * 256 + 128 + c0); }
#pragma unroll
        for (int k = 0; k < U; ++k) {
            float d[8];
            d[0] = bflo(a[k].x) - lam * bflo(b[k].x); d[1] = bfhi(a[k].x) - lam * bfhi(b[k].x); d[2] = bflo(a[k].y) - lam * bflo(b[k].y); d[3] = bfhi(a[k].y) - lam * bfhi(b[k].y);
            d[4] = bflo(a[k].z) - lam * bflo(b[k].z); d[5] = bfhi(a[k].z) - lam * bfhi(b[k].z); d[6] = bflo(a[k].w) - lam * bflo(b[k].w); d[7] = bfhi(a[k].w) - lam * bfhi(b[k].w);
            float s = 0.f;
#pragma unroll
            for (int j = 0; j < 8; ++j) s += d[j] * d[j];
            s += __shfl_xor(s, 1); s += __shfl_xor(s, 2); s += __shfl_xor(s, 4); s += __shfl_xor(s, 8);
            const float rs = rsqrtf(s * (1.f / 128.f) + EPS);
            u32x4 w; w.x = pk2(d[0] * rs, d[1] * rs); w.y = pk2(d[2] * rs, d[3] * rs); w.z = pk2(d[4] * rs, d[5] * rs); w.w = pk2(d[6] * rs, d[7] * rs);
            if (r0 + k * ngw < NR) *(u32x4*)(proj + (size_t)row[k] * DIN + SEG_DQ + h * 128 + c0) = w;
        }
    }
}
__device__ __forceinline__ void stage_final(const Params& p, int gw, int ngw, int lane) {
    const u64* ss = (const u64*)(p.ws + WS_CTL + CTL_SS) + 6 * MP; const float* g = p.in[19];
    f32x4 gg[4];
#pragma unroll
    for (int j = 0; j < 4; ++j) gg[j] = *(const f32x4*)(g + 4 * lane + 256 * j);
    for (int r0 = gw; r0 < NREAL; r0 += 2 * ngw) {
        const int r1 = r0 + ngw < NREAL ? r0 + ngw : r0;
        float* h0 = p.out + (size_t)r0 * D; float* h1 = p.out + (size_t)r1 * D;
        const u64 s0 = ss[r0], s1 = ss[r1];
        f32x4 v0[4], v1[4];
#pragma unroll
        for (int j = 0; j < 4; ++j) { v0[j] = *(const f32x4*)(h0 + 4 * lane + 256 * j); v1[j] = *(const f32x4*)(h1 + 4 * lane + 256 * j); }
        const float rs0 = rsqrtf((float)s0 * SS_INV + EPS), rs1 = rsqrtf((float)s1 * SS_INV + EPS);
#pragma unroll
        for (int j = 0; j < 4; ++j) *(f32x4*)(h0 + 4 * lane + 256 * j) = v0[j] * rs0 * gg[j];
        if (r1 != r0) {
#pragma unroll
            for (int j = 0; j < 4; ++j) *(f32x4*)(h1 + 4 * lane + 256 * j) = v1[j] * rs1 * gg[j];
        }
    }
}

#ifndef XB_WG_REL
#define XB_WG_REL 0
#endif
#ifndef XB_STRONG_REL
#define XB_STRONG_REL 0
#endif
#ifndef XB_STRONG_ACQ
#define XB_STRONG_ACQ 0
#endif
#define XB_TMO      128
#define XB_XCNT(j)  (256  + 64 * (j))
#define XB_XSUB(j)  (1280 + 64 * (j))
#define XB_XGEN(j)  (2304 + 64 * (j))
#define XB_TOP      3328
#define XB_TOPGEN   3392
#define XCD_BAR_WORDS 3456
#define XB_SPIN_CAP (1u << 18)
__device__ __forceinline__ unsigned xb_ld(unsigned* p)              { return __hip_atomic_load(p, __ATOMIC_RELAXED, __HIP_MEMORY_SCOPE_AGENT); }
__device__ __forceinline__ unsigned xb_add(unsigned* p, unsigned v) { return __hip_atomic_fetch_add(p, v, __ATOMIC_RELAXED, __HIP_MEMORY_SCOPE_AGENT); }
__device__ __forceinline__ unsigned xb_xcc_id() { return (unsigned)__builtin_amdgcn_s_getreg((3 << 11) | 20) & 0xFu; }
#define XB_SPIN(cond, bar) do { unsigned _sp = 0; while (cond) { __builtin_amdgcn_s_sleep(1); \
    if ((++_sp & 255u) == 0u) { if (xb_ld(&(bar)[XB_TMO])) break; if (_sp > XB_SPIN_CAP) { atomicAdd(&(bar)[XB_TMO], 1u); break; } } } } while (0)
struct XcdBarrier { unsigned* bar; unsigned x; volatile LAS unsigned* st; };
__device__ __forceinline__ XcdBarrier xcd_barrier_post(unsigned* bar, volatile LAS unsigned* st) {
    XcdBarrier b; b.bar = bar; b.x = xb_xcc_id(); b.st = st;
    if (threadIdx.x == 0) (void)xb_add(&bar[XB_XCNT(b.x)], 1u);
    return b;
}
__device__ __forceinline__ void xcd_barrier_complete(unsigned* bar, unsigned x, unsigned& nloc, unsigned& nx) {
    const unsigned G = gridDim.x * gridDim.y * gridDim.z;
    unsigned sum, cnt, mine, sp = 0u;
    for (;;) {
        sum = 0u; cnt = 0u; mine = 0u;
#pragma unroll
        for (unsigned j = 0; j < 16; ++j) { const unsigned c = xb_ld(&bar[XB_XCNT(j)]); sum += c; cnt += (c > 0u) ? 1u : 0u; mine = (j == x) ? c : mine; }
        if (sum == G) break;
        __builtin_amdgcn_s_sleep(1);
        if ((++sp & 255u) == 0u) { if (xb_ld(&bar[XB_TMO])) break; if (sp > XB_SPIN_CAP) { atomicAdd(&bar[XB_TMO], 1u); break; } }
    }
    nloc = mine > 0u ? mine : 1u; nx = cnt > 0u ? cnt : 1u;
}
__device__ __forceinline__ void xcd_barrier(const XcdBarrier& b) {
    asm volatile("s_waitcnt vmcnt(0)" ::: "memory");
#if XB_STRONG_REL
    __builtin_amdgcn_fence(__ATOMIC_RELEASE, "agent");
    asm volatile("s_waitcnt vmcnt(0)" ::: "memory");
#endif
    __syncthreads();
    if (threadIdx.x == 0) {
        unsigned* bar = b.bar;
        __builtin_amdgcn_s_waitcnt(0);
#if XB_WG_REL
        __builtin_amdgcn_fence(__ATOMIC_RELEASE, "agent");
        asm volatile("s_waitcnt vmcnt(0)" ::: "memory");
#endif
        unsigned nloc = b.st[0], nx = b.st[1];
        if (nloc == 0u) { xcd_barrier_complete(bar, b.x, nloc, nx); b.st[0] = nloc; b.st[1] = nx; }
        const unsigned old = xb_add(&bar[XB_XSUB(b.x)], 1u);
        const unsigned gen = old / nloc;
        if (old + 1u == (gen + 1u) * nloc) {
            __builtin_amdgcn_fence(__ATOMIC_RELEASE, "agent");
            asm volatile("s_waitcnt vmcnt(0)" ::: "memory");
            const unsigned og = xb_add(&bar[XB_TOP], 1u);
            const unsigned tg = og / nx;
            if (og + 1u == (tg + 1u) * nx) xb_add(&bar[XB_TOPGEN], 1u);
            else XB_SPIN(xb_ld(&bar[XB_TOPGEN]) == tg, bar);
            __builtin_amdgcn_fence(__ATOMIC_ACQUIRE, "agent");
            xb_add(&bar[XB_XGEN(b.x)], 1u);
            asm volatile("s_waitcnt vmcnt(0)" ::: "memory");
        } else {
            XB_SPIN(xb_ld(&bar[XB_XGEN(b.x)]) == gen, bar);
            __builtin_amdgcn_fence(__ATOMIC_ACQUIRE, "agent");
            asm volatile("s_waitcnt vmcnt(0)" ::: "memory");
        }
    }
    __syncthreads();
#if XB_STRONG_ACQ
    __builtin_amdgcn_fence(__ATOMIC_ACQUIRE, "agent");
    asm volatile("s_waitcnt vmcnt(0)" ::: "memory");
    __syncthreads();
#endif
}

#ifndef MK_ONE_LAUNCH
#define MK_ONE_LAUNCH 1
#endif
constexpr int NTHREADS = 512, LDS_BYTES = 147456, RING_BYTES = 131072, MISC_OFF = RING_BYTES + 320;
constexpr int CW_BAR = 4096;
constexpr int CW_RET = 8192;
constexpr int CW_FIN = 12288;
static_assert(CW_BAR + XCD_BAR_WORDS <= CW_RET && CW_RET + 6 * 64 <= CW_FIN && (CW_FIN + 64 * 64) * 4 <= (int)CTL_MEMSET && CTL_MEMSET <= CTL_SS, "ctl map");
constexpr int NPHASES = 20;

__global__ void __launch_bounds__(NTHREADS, 2) k_mega(Params p) {
    extern __shared__ __attribute__((aligned(16))) unsigned char lds[];
    const int tid = threadIdx.x, lane = tid & 63, wave = __builtin_amdgcn_readfirstlane(tid >> 6);
    const int G = gridDim.x, wg = blockIdx.x, vcu = (G % 8 == 0) ? (wg % 8) * (G / 8) + wg / 8 : wg;
    const int gw = wg * 8 + wave, ngw = G * 8, gtid = wg * NTHREADS + tid, ngt = G * NTHREADS;
    u64* ssb = (u64*)(p.ws + WS_CTL + CTL_SS);
    bf16* hb = (bf16*)(p.ws + WS_HB); bf16* proj = (bf16*)(p.ws + WS_PROJ); bf16* act = (bf16*)(p.ws + WS_PROJ);
    unsigned char* wb = p.ws + WS_W; float* hm = (float*)(p.ws + WS_HM);
    LAS float* scr = (LAS float*)((LAS unsigned char*)lds + wave * 16384);
    volatile LAS unsigned* MISC = (volatile LAS unsigned*)((LAS unsigned char*)lds + MISC_OFF);
    if (tid < 32) MISC[tid] = 0u;
    __syncthreads();
    XcdBarrier bar = xcd_barrier_post((unsigned*)(p.ws + WS_CTL) + CW_BAR, MISC + 8);
#define PH(k, ...) do { if (p.ph_lo <= (k) && (k) < p.ph_hi) { __VA_ARGS__; if ((k) + 1 < p.ph_hi) xcd_barrier(bar); } } while (0)
    const int cw0 = (G - G / 2) > 64 ? 32 : 0;
    const int tw = (wg - G / 2 - cw0) * 8 + wave, ntw = (G - G / 2 - cw0) * 8;
    PH(0, stage_prologue(p, gw, ngw, lane, gtid, ngt); convert_set(p, 0, 1, scr, gw, ngw, lane));
    bf16* actm = (bf16*)(p.ws + WS_ACTM) - (size_t)MROW0 * FF;
    unsigned* mcnt = (unsigned*)(p.ws + WS_CTL) + CW_RET;
    const int tg = wg - G / 2, tgs = G - G / 2;
    const int pre1k = (tg >= 0 && tg < 32) ? tg : -1;
#define LAYER(l, pb) do { \
        PH(pb + 0, { EpiSwiGLU E{ssb + (3 * l) * MP, act}; EpiSwiGLU Em{ssb + (3 * l) * MP, actm}; \
            GEMM(true, hb, D, (const bf16*)(wb + W_GU1), MP, 2 * FF, D, E); \
            if (tg >= 0) { \
                if (l == 1) { EpiResidT<0> Ep{p.in[0], p.out, hm, hb, ssb + (3 * l) * MP, 0.5f}; gemm_meta<false>((LAS unsigned char*)lds, actm, FF, (const bf16*)(wb + W_D2), D, FF, Ep, pre1k, tgs, wave, lane, mcnt + (3 * l) * 64); } \
                if (tg >= cw0) convert_set(p, l, 2 | 4, scr, tw, ntw, lane); \
                if (l == 1) meta_wait(mcnt + (3 * l) * 64, 32u); \
                gemm_meta<true>((LAS unsigned char*)lds, hb, D, (const bf16*)(wb + W_GU1), 2 * FF, D, Em, tg, tgs, wave, lane); } }); \
        PH(pb + 1, { if (l == 0) { EpiResidT<1> E{p.in[0], p.out, hm, hb, ssb + (3 * l + 1) * MP, 0.5f}; GEMM(false, act, FF, (const bf16*)(wb + W_D1), MP, D, FF, E); } \
                     else { EpiResidT<0> E{p.in[0], p.out, hm, hb, ssb + (3 * l + 1) * MP, 0.5f}; GEMM(false, act, FF, (const bf16*)(wb + W_D1), MP, D, FF, E); } }); \
        PH(pb + 2, { EpiInProj E{ssb + (3 * l + 1) * MP, proj, (const h2_t*)(p.ws + WS_TAB), (const h2_t*)(p.ws + WS_TAB + TAB_P)}; \
            GEMM(false, hb, D, (const bf16*)(wb + W_IN), MP, DIN, D, E); \
            if (tg >= 0) { \
                if (l == 0) { EpiResidT<1> Ep{p.in[0], p.out, hm, hb, ssb + (3 * l + 1) * MP, 0.5f}; gemm_meta<false>((LAS unsigned char*)lds, actm, FF, (const bf16*)(wb + W_D1), D, FF, Ep, pre1k, tgs, wave, lane, mcnt + (3 * l + 1) * 64); } \
                else { EpiResidT<0> Ep{p.in[0], p.out, hm, hb, ssb + (3 * l + 1) * MP, 0.5f}; gemm_meta<false>((LAS unsigned char*)lds, actm, FF, (const bf16*)(wb + W_D1), D, FF, Ep, pre1k, tgs, wave, lane, mcnt + (3 * l + 1) * 64); } \
                if (tg >= cw0) convert_set(p, l, 8 | 16, scr, tw, ntw, lane); \
                meta_wait(mcnt + (3 * l + 1) * 64, 32u); \
                gemm_meta<false>((LAS unsigned char*)lds, hb, D, (const bf16*)(wb + W_IN), DIN, D, E, tg, tgs, wave, lane); } }); \
        PH(pb + 3, stage_attn_fast(p, (char*)lds, vcu, G); stage_attn_naive(p, 512, vcu == G - 1 ? 0 : 1, G, tid); \
                   stage_ret_states(p, (LAS unsigned char*)lds, vcu, G, tid); stage_ret_outs(p, (LAS unsigned char*)lds, 512 + ((vcu + G - 228) % G), G, 516, tid)); \
        PH(pb + 4, stage_ret_scan(p, gtid, ngt); stage_combine(p, l, gw, ngw, lane)); \
        PH(pb + 5, stage_ret_outs(p, (LAS unsigned char*)lds, vcu, G, 512, tid)); \
        PH(pb + 6, { EpiResidT<0> E{p.in[0], p.out, hm, hb, ssb + (3 * l + 2) * MP, 1.0f}; GEMM(false, proj + YCOL, DIN, (const bf16*)(wb + W_OUT), MP, D, D, E); }); \
        PH(pb + 7, { EpiSwiGLU E{ssb + (3 * l + 2) * MP, act}; EpiSwiGLU Em{ssb + (3 * l + 2) * MP, actm}; \
            GEMM(true, hb, D, (const bf16*)(wb + W_GU2), MP, 2 * FF, D, E); \
            if (tg >= 0) { \
                if (l == 0) { EpiResidT<0> Ep{p.in[0], p.out, hm, hb, ssb + (3 * l + 2) * MP, 1.0f}; gemm_meta<false>((LAS unsigned char*)lds, proj + YCOL, DIN, (const bf16*)(wb + W_OUT), D, D, Ep, pre1k, tgs, wave, lane, mcnt + (3 * l + 2) * 64); } \
                if (tg >= cw0) { convert_set(p, l, 32, scr, tw, ntw, lane); if (l == 0) convert_set(p, 1, 1, scr, tw, ntw, lane); } \
                if (l == 0) { meta_wait(mcnt + (3 * l + 2) * 64, 32u); gemm_meta<true>((LAS unsigned char*)lds, hb, D, (const bf16*)(wb + W_GU2), 2 * FF, D, Em, tg, tgs, wave, lane); } } }); \
        PH(pb + 8, { if (l == 0) { EpiResidT<0> E{p.in[0], p.out, hm, hb, ssb + (3 * l + 3) * MP, 0.5f}; GEMM(false, act, FF, (const bf16*)(wb + W_D2), MP, D, FF, E); } \
                     else if (G != 256) { EpiResidT<2> E{p.in[0], p.out, hm, hb, ssb + (3 * l + 3) * MP, 0.5f}; GEMM(false, act, FF, (const bf16*)(wb + W_D2), MP, D, FF, E); } \
                     else { EpiFinalFused E{hb, p.out, p.in[19], (unsigned*)(p.ws + WS_XCH), (unsigned*)(p.ws + WS_CTL) + CW_FIN, 0.5f}; \
                            pg8::Gemm g{act, (const bf16*)(wb + W_D2), NREAL, D, FF, FF}; pg8::StaticOrder S; S.init(NREAL, D, G, wg); pg8::gemm_phase<EpiFinalFused, pg8::StaticOrder, false, true>((LAS unsigned char*)lds, g, S, E); } }); \
    } while (0)
    LAYER(0, 1);
    LAYER(1, 10);
#undef LAYER
    if (G != 256) PH(19, stage_final(p, gw, ngw, lane));
#undef PH
}

extern "C" void kernel_launch(void* const* d_in, const int* in_sizes, int n_in, void* d_out, int out_size, void* d_ws, size_t ws_size, hipStream_t stream) {
    static int grid = 0;
    if (grid == 0) {
        if (n_in != 20 || out_size != NREAL * D || ws_size < WS_END) { fprintf(stderr, "kernel_launch: unexpected shapes (n_in %d out %d ws %zu)\n", n_in, out_size, ws_size); grid = -1; return; }
        int dev = 0, cus = 0, per_cu = 0;
        (void)hipGetDevice(&dev); (void)hipDeviceGetAttribute(&cus, hipDeviceAttributeMultiprocessorCount, dev);
        (void)hipFuncSetAttribute((const void*)k_mega, hipFuncAttributeMaxDynamicSharedMemorySize, LDS_BYTES);
        (void)hipOccupancyMaxActiveBlocksPerMultiprocessor(&per_cu, (const void*)k_mega, NTHREADS, LDS_BYTES);
        (void)hipGetLastError();
        if (per_cu < 1) { fprintf(stderr, "kernel_launch: occupancy query reports %d blocks per CU; nothing launched\n", per_cu); grid = -1; return; }
        grid = cus > 0 ? cus : 256;
    }
    if (grid < 0) return;
    (void)hipMemsetAsync((char*)d_ws + WS_CTL, 0, CTL_MEMSET, stream);
    Params p{};
    for (int i = 0; i < 20; ++i) p.in[i] = (const float*)d_in[i];
    p.out = (float*)d_out; p.ws = (unsigned char*)d_ws;
#if MK_ONE_LAUNCH
    p.ph_lo = 0; p.ph_hi = grid == 256 ? NPHASES - 1 : NPHASES;
    hipLaunchKernelGGL(k_mega, dim3(grid), dim3(NTHREADS), LDS_BYTES, stream, p);
#else
    for (int pc = 0; pc < NPHASES; ++pc) { p.ph_lo = pc; p.ph_hi = pc + 1; hipLaunchKernelGGL(k_mega, dim3(grid), dim3(NTHREADS), LDS_BYTES, stream, p); }
#endif
}
```

```cpp
#include <hip/hip_runtime.h>
#include <cstdio>
#include <cstdint>
#include <cmath>
#include <hip/hip_bf16.h>

#define GAS __attribute__((address_space(1)))
#define LAS __attribute__((address_space(3)))
typedef unsigned short bf16;
typedef short bf16x8 __attribute__((ext_vector_type(8)));
typedef float f32x4 __attribute__((ext_vector_type(4)));
typedef unsigned u32x4 __attribute__((ext_vector_type(4)));
typedef unsigned u32x2 __attribute__((ext_vector_type(2)));
typedef _Float16 h2_t __attribute__((ext_vector_type(2)));
__device__ __forceinline__ h2_t as_h2(unsigned w) { return __builtin_bit_cast(h2_t, w); }

constexpr int D = 1024, FF = 2816, DIN = 3584, SEQ = 2048, NBATCH = 8, NMETA = 16;
constexpr int NREAL = NBATCH * SEQ;
constexpr int MROW0 = NREAL + 48;
constexpr int MP = NREAL + 256;
constexpr int NPOS = NMETA + SEQ;
constexpr float EPS = 1e-6f;
constexpr float C2 = 0.125f * 1.4426950408889634f;
constexpr int SEG_RQ = 0, SEG_RK = 512, SEG_RV = 1024, SEG_RG = 1536, SEG_DQ = 2048, SEG_DK = 2560, SEG_DV = 3072, YCOL = 1536;

constexpr size_t MiB = 1u << 20;
constexpr size_t WS_CTL = 0, CTL_BYTES = 2 * MiB, CTL_MEMSET = 64 * 1024;
constexpr size_t CTL_SS = 256 * 1024;
typedef unsigned long long u64;
constexpr float SS_SCALE = 16777216.f, SS_INV = 1.f / (16777216.f * 1024.f);
static_assert(CTL_SS + (size_t)7 * (NREAL + 256) * 8 <= 2 * MiB, "ctl");
constexpr size_t WS_TAB = 2 * MiB;
constexpr size_t TAB_P = (size_t)NPOS * 64 * 8, TAB_LAM = TAB_P + (size_t)NPOS * 8 * 8;
constexpr size_t WS_W = 4 * MiB;
constexpr size_t W_GU1 = 0, W_D1 = W_GU1 + (size_t)2 * FF * D * 2, W_IN = W_D1 + (size_t)D * FF * 2, W_OUT = W_IN + (size_t)DIN * D * 2,
                 W_GU2 = W_OUT + (size_t)D * D * 2, W_D2 = W_GU2 + (size_t)2 * FF * D * 2, W_END = W_D2 + (size_t)D * FF * 2;
static_assert(W_END == 42 * MiB, "weights");
constexpr size_t WS_HB = 46 * MiB;
constexpr size_t WS_PROJ = WS_HB + (size_t)MP * D * 2;
constexpr size_t WS_OP = WS_PROJ + (size_t)MP * DIN * 2;
constexpr size_t WS_HM = WS_OP + (size_t)MP * D * 2;
constexpr size_t WS_RP = WS_HM + (size_t)256 * D * 4;
constexpr size_t WS_ACTM = WS_RP + (size_t)512 * 16384 * 2;
constexpr size_t WS_XCH = WS_ACTM + (size_t)NMETA * FF * 2 + 256;
constexpr size_t WS_END = WS_XCH + (size_t)NREAL * 4 * 4;
static_assert(WS_END <= 256 * MiB, "d_ws map");

struct Params {
    const float* in[20];
    float* out;
    unsigned char* ws;
    int ph_lo, ph_hi;
};

__device__ __forceinline__ unsigned f2bf(float f) { unsigned u = __builtin_bit_cast(unsigned, f); return (u + 0x7fffu + ((u >> 16) & 1u)) >> 16; }
typedef float f32x2_t __attribute__((ext_vector_type(2))); typedef __bf16 bf16x2_t __attribute__((ext_vector_type(2)));
__device__ __forceinline__ unsigned pk2(float lo, float hi) { f32x2_t v = {lo, hi}; bf16x2_t b = __builtin_convertvector(v, bf16x2_t); return __builtin_bit_cast(unsigned, b); }
__device__ __forceinline__ float bflo(unsigned u) { return __builtin_bit_cast(float, u << 16); }
__device__ __forceinline__ float bfhi(unsigned u) { return __builtin_bit_cast(float, u & 0xffff0000u); }
__device__ __forceinline__ float bf2f(bf16 b) { return __builtin_bit_cast(float, (unsigned)b << 16); }
__device__ __forceinline__ int perm32(int rho) { const int n = rho >> 4, i = rho & 15; return 8 * (i >> 2) + 4 * n + (i & 3); }
__device__ __forceinline__ float wave_sum(float v) {
#pragma unroll
    for (int o = 1; o < 64; o <<= 1) v += __shfl_xor(v, o);
    return v;
}
__device__ __forceinline__ float silu(float x) { return x * __builtin_amdgcn_rcpf(1.f + __expf(-x)); }
typedef float f32x2 __attribute__((ext_vector_type(2)));
__device__ __forceinline__ f32x2 sigmoid2(f32x2 x) { const f32x2 t = x * (-1.4426950408889634f); f32x2 e; e.x = __builtin_amdgcn_exp2f(t.x); e.y = __builtin_amdgcn_exp2f(t.y);
    const f32x2 d = e + 1.0f; const float r = __builtin_amdgcn_rcpf(d.x * d.y);
    return (f32x2){d.y, d.x} * r; }
__device__ __forceinline__ float ss_rstd(unsigned long long v) { const float f = __builtin_fmaf((float)(unsigned)(v >> 32), 4294967296.f, (float)(unsigned)v); return __builtin_amdgcn_rsqf(f * (1.f / (16777216.f * 1024.f)) + 1e-6f); }
__device__ __forceinline__ float* hrow(float* out, float* hm, int row) {
    return row < NREAL ? out + (size_t)row * D : hm + (size_t)(row - NREAL) * D;
}
__device__ __forceinline__ float lambda_init(int l) { return l == 0 ? 0.2f : 0.8f - 0.6f * 0.7408182206817179f; }
__device__ __forceinline__ float log2gamma(int h) { return h == 0 ? -0.04580368961312479f : h == 1 ? -0.02272007650008353f : h == 2 ? -0.011315313227834146f : -0.005646563141142063f; }
__device__ __forceinline__ int row_pos(int row) { return row < NREAL ? NMETA + (row & (SEQ - 1)) : (row >= MROW0 && row < MROW0 + NMETA ? row - MROW0 : 0); }
__device__ __forceinline__ int row_il(int row) { return row < NREAL ? (row & 127) : (row >= MROW0 && row < MROW0 + NMETA ? 112 + row - MROW0 : 0); }

__device__ __forceinline__ void stage_prologue(const Params& p, int gw, int ngw, int lane, int gtid, int ngt) {
    const float* x = p.in[0]; const float* meta = p.in[1];
    bf16* hb = (bf16*)(p.ws + WS_HB); u64* ss0 = (u64*)(p.ws + WS_CTL + CTL_SS);
    for (int r0 = gw; r0 < NREAL; r0 += 4 * ngw) {
        f32x4 v[4][4]; int row[4];
#pragma unroll
        for (int k = 0; k < 4; ++k) { row[k] = r0 + k * ngw < NREAL ? r0 + k * ngw : r0;
#pragma unroll
            for (int j = 0; j < 4; ++j) v[k][j] = *(const f32x4*)(x + (size_t)row[k] * D + 4 * lane + 256 * j); }
#pragma unroll
        for (int k = 0; k < 4; ++k) {
            float s = 0.f;
#pragma unroll
            for (int j = 0; j < 4; ++j) s += (v[k][j].x * v[k][j].x + v[k][j].y * v[k][j].y) + (v[k][j].z * v[k][j].z + v[k][j].w * v[k][j].w);
            s = wave_sum(s);
            if (k == 0 || row[k] != r0) {
#pragma unroll
                for (int j = 0; j < 4; ++j) { u32x2 w; w.x = pk2(v[k][j].x, v[k][j].y); w.y = pk2(v[k][j].z, v[k][j].w); *(u32x2*)(hb + (size_t)row[k] * D + 4 * lane + 256 * j) = w; }
                if (lane == 0) ss0[row[k]] = (u64)(s * SS_SCALE);
            }
        }
    }
    for (int row = NREAL + gw; row < MP; row += ngw) {
        f32x4 v[4];
        const bool ismeta = (row >= MROW0 && row < MROW0 + NMETA);
        const float* src = meta + (size_t)(ismeta ? row - MROW0 : 0) * D;
        float s = 0.f;
#pragma unroll
        for (int j = 0; j < 4; ++j) {
            v[j] = ismeta ? *(const f32x4*)(src + 4 * lane + 256 * j) : (f32x4){0.f, 0.f, 0.f, 0.f};
            s += (v[j].x * v[j].x + v[j].y * v[j].y) + (v[j].z * v[j].z + v[j].w * v[j].w);
        }
        s = wave_sum(s);
        float* hr = (float*)(p.ws + WS_HM) + (size_t)(row - NREAL) * D;
#pragma unroll
        for (int j = 0; j < 4; ++j) {
            *(f32x4*)(hr + 4 * lane + 256 * j) = v[j];
            u32x2 w; w.x = pk2(v[j].x, v[j].y); w.y = pk2(v[j].z, v[j].w);
            *(u32x2*)(hb + (size_t)row * D + 4 * lane + 256 * j) = w;
        }
        if (lane == 0) ss0[row] = (u64)(s * SS_SCALE);
    }
    for (int e = gtid; e < 6 * MP; e += ngt) ss0[MP + e] = 0ull;
    for (int e = gtid; e < 48 * DIN / 8; e += ngt) *(u32x4*)((bf16*)(p.ws + WS_PROJ) + (size_t)NREAL * DIN + (size_t)e * 8) = (u32x4){0u, 0u, 0u, 0u};
    h2_t* rtab = (h2_t*)(p.ws + WS_TAB); h2_t* ptab = (h2_t*)(p.ws + WS_TAB + TAB_P); float* lam = (float*)(p.ws + WS_TAB + TAB_LAM);
    for (int e = gtid; e < NPOS * 64; e += ngt) {
        const int pos = e >> 6, i = e & 63;
        const double ang = exp(-log(10000.0) * (double)i / 63.0), f = (double)pos * ang;
        rtab[e] = (h2_t){(_Float16)(float)cos(f), (_Float16)(float)sin(f)};
    }
    for (int e = gtid; e < NPOS * 8; e += ngt) {
        const int pos = e >> 3, j = e & 7;
        const double inv = exp(-log(500000.0) * (double)j / 8.0), f = (double)pos * inv;
        ptab[e] = (h2_t){(_Float16)(float)cos(f), (_Float16)(float)sin(f)};
    }
    if (gtid < 2) {
        const int l = gtid; float s1 = 0.f, s2 = 0.f;
        for (int i = 0; i < 64; ++i) { s1 += p.in[10][l * 64 + i] * p.in[11][l * 64 + i]; s2 += p.in[12][l * 64 + i] * p.in[13][l * 64 + i]; }
        lam[l] = expf(s1) - expf(s2) + lambda_init(l);
    }
}

__device__ __forceinline__ void conv_item(const float* W, int K, int N, bf16* WT, int item, int gu_half  , int mode,
                                          const float* ks, const float* ks2, float mul2, LAS float* scr, int lane) {
    const int nblk = N / 32, kb = item / nblk, nb = item % nblk, k0 = 64 * kb, n0 = 32 * nb;
    const int row0 = gu_half < 0 ? n0 : 256 * (n0 / 128) + (n0 % 128) + 128 * gu_half;
    f32x4 v[8];
#pragma unroll
    for (int i = 0; i < 8; ++i) v[i] = *(const f32x4*)(W + (size_t)(k0 + 8 * i + (lane >> 3)) * N + n0 + 4 * (lane & 7));
#pragma unroll
    for (int i = 0; i < 8; ++i) {
        const int kk = 8 * i + (lane >> 3), k = k0 + kk;
        float sc = 1.f;
        if (mode == 1) sc = ks[k];
        else if (mode == 2) sc = k < 512 ? ks[k] : ks2[(k - 512) & 127] * mul2;
        LAS float* d = scr + kk * 33 + 4 * (lane & 7);
        d[0] = v[i].x * sc; d[1] = v[i].y * sc; d[2] = v[i].z * sc; d[3] = v[i].w * sc;
    }
    asm volatile("s_waitcnt lgkmcnt(0)" ::: "memory");
    const int c = lane & 7;
#pragma unroll
    for (int j = 0; j < 4; ++j) {
        const int n = (lane >> 3) + 8 * j; const LAS float* s = scr + (8 * c) * 33 + n;
        u32x4 o; o.x = pk2(s[0 * 33], s[1 * 33]); o.y = pk2(s[2 * 33], s[3 * 33]); o.z = pk2(s[4 * 33], s[5 * 33]); o.w = pk2(s[6 * 33], s[7 * 33]);
        *(u32x4*)(WT + (size_t)(row0 + n) * K + k0 + 8 * c) = o;
    }
    asm volatile("s_waitcnt lgkmcnt(0)" ::: "memory");
}
constexpr int I_GU = (D / 64) * (FF / 32), I_D = (FF / 64) * (D / 32), I_IN = (D / 64) * (DIN / 32), I_O = (D / 64) * (D / 32);
__device__ __forceinline__ void convert_set(const Params& p, int l, int mask, LAS float* scr, int w, int nw, int lane) {
    unsigned char* wb = p.ws + WS_W;
    const size_t oGU = (size_t)l * D * FF, oD = (size_t)l * FF * D;
    if (mask & 1) for (int r = w; r < 2 * I_GU; r += nw) { const int half = r >= I_GU; conv_item((half ? p.in[4] : p.in[3]) + oGU, D, FF, (bf16*)(wb + W_GU1), r - half * I_GU, half, 1, p.in[2] + l * D, nullptr, 0.f, scr, lane); }
    if (mask & 2) for (int r = w; r < I_D; r += nw) conv_item(p.in[5] + oD, FF, D, (bf16*)(wb + W_D1), r, -1, 0, nullptr, nullptr, 0.f, scr, lane);
    if (mask & 4) for (int r = w; r < I_IN; r += nw) conv_item(p.in[7] + (size_t)l * D * DIN, D, DIN, (bf16*)(wb + W_IN), r, -1, 1, p.in[6] + l * D, nullptr, 0.f, scr, lane);
    if (mask & 8) for (int r = w; r < I_O; r += nw) conv_item(p.in[14] + (size_t)l * D * D, D, D, (bf16*)(wb + W_OUT), r, -1, 2, p.in[8] + l * 512, p.in[9] + l * 128, 1.f - lambda_init(l), scr, lane);
    if (mask & 16) for (int r = w; r < 2 * I_GU; r += nw) { const int half = r >= I_GU; conv_item((half ? p.in[17] : p.in[16]) + oGU, D, FF, (bf16*)(wb + W_GU2), r - half * I_GU, half, 1, p.in[15] + l * D, nullptr, 0.f, scr, lane); }
    if (mask & 32) for (int r = w; r < I_D; r += nw) conv_item(p.in[18] + oD, FF, D, (bf16*)(wb + W_D2), r, -1, 0, nullptr, nullptr, 0.f, scr, lane);
}

struct EpiSwiGLU {
    typedef u64 Ctx;
    const u64* ss; bf16* act;
    __device__ __forceinline__ Ctx load(int row, int) const { return ss[row]; }
    __device__ __forceinline__ void pair(int row, int oc, const Ctx& c, f32x4 g0, f32x4 g1, f32x4 u0, f32x4 u1) const {
        const float rs = ss_rstd(c), rs2 = rs * rs;
        const f32x2 g[4] = {(f32x2){g0.x, g0.y}, (f32x2){g0.z, g0.w}, (f32x2){g1.x, g1.y}, (f32x2){g1.z, g1.w}}, uu[4] = {(f32x2){u0.x, u0.y}, (f32x2){u0.z, u0.w}, (f32x2){u1.x, u1.y}, (f32x2){u1.z, u1.w}};
        f32x2 o[4];
#pragma unroll
        for (int k = 0; k < 4; ++k) o[k] = ((g[k] * uu[k]) * rs2) * sigmoid2(g[k] * rs);
        u32x4 w; w.x = pk2(o[0].x, o[0].y); w.y = pk2(o[1].x, o[1].y); w.z = pk2(o[2].x, o[2].y); w.w = pk2(o[3].x, o[3].y);
        *(u32x4*)(act + (size_t)row * FF + oc) = w;
    }
};
template <int MODE> struct EpiResidT {
    struct Ctx { f32x4 a, b; };
    static constexpr bool PER_BJ = true;
    static constexpr int RB = MODE == 1 ? 2 : 4;
    const float* base; float* out; const float* hm; bf16* hb; u64* ssn; float scale;
    __device__ __forceinline__ Ctx load(int row, int col0) const {
        Ctx c;
        if (MODE == 1) { const float* br = row < NREAL ? base + (size_t)row * D + col0 : hm + (size_t)(row - NREAL) * D + col0; c.a = *(const f32x4*)br; c.b = *(const f32x4*)(br + 4); }
        else { const u32x4 w = *(const u32x4*)(hb + (size_t)row * D + col0); c.a = __builtin_bit_cast(f32x4, w); }
        return c;
    }
    __device__ __forceinline__ void row8(int row, int col0, const Ctx& c, f32x4 v0, f32x4 v1) const {
        f32x4 ra, rb;
        if (MODE == 1) { ra = c.a; rb = c.b; }
        else { const u32x4 w = __builtin_bit_cast(u32x4, c.a); ra = (f32x4){bflo(w.x), bfhi(w.x), bflo(w.y), bfhi(w.y)}; rb = (f32x4){bflo(w.z), bfhi(w.z), bflo(w.w), bfhi(w.w)}; }
        const f32x4 a = ra + v0 * scale, b = rb + v1 * scale;
        if (MODE == 2) { if (row < NREAL) { float* hr = out + (size_t)row * D + col0; *(f32x4*)hr = a; *(f32x4*)(hr + 4) = b; } }
        else { u32x4 w; w.x = pk2(a.x, a.y); w.y = pk2(a.z, a.w); w.z = pk2(b.x, b.y); w.w = pk2(b.z, b.w); *(u32x4*)(hb + (size_t)row * D + col0) = w; }
        float s = (a.x * a.x + a.y * a.y) + (a.z * a.z + a.w * a.w) + (b.x * b.x + b.y * b.y) + (b.z * b.z + b.w * b.w);
        s += __shfl_xor(s, 16); s += __shfl_xor(s, 32);
        if ((threadIdx.x & 48) == 0) atomicAdd(ssn + row, (u64)(s * SS_SCALE));
    }
};
struct EpiInProj {
    struct Ctx { u64 ss; u32x4 ta, tb; };
    static constexpr bool PER_BJ = false;
    static constexpr int RB = 4;
    const u64* ss; bf16* proj; const h2_t* rtab; const h2_t* ptab;
    __device__ __forceinline__ Ctx load(int row, int col0) const {
        Ctx c; c.ss = ss[row];
        const int seg = col0 >> 9, pos = row_pos(row);
        const u32x4* ta = seg <= 1 ? (const u32x4*)(rtab + pos * 64 + ((col0 & 127) >> 1)) : (const u32x4*)(ptab + pos * 8);
        c.ta = ta[0]; c.tb = ((const u32x4*)(ptab + pos * 8))[1];
        return c;
    }
    __device__ __forceinline__ void row8(int row, int col0, const Ctx& c, f32x4 v0, f32x4 v1) const {
        const float rs = ss_rstd(c.ss);
        float x[8];
#pragma unroll
        for (int j = 0; j < 4; ++j) { x[j] = v0[j] * rs; x[4 + j] = v1[j] * rs; }
        const int seg = col0 >> 9;
        if (seg <= 1) {
            const int h = (col0 >> 7) & 3;
            const float e = (float)(row_il(row) + 1) * log2gamma(h);
            const float f = seg == 0 ? __builtin_amdgcn_exp2f(e) : __builtin_amdgcn_exp2f(-e) * 0.08838834764831845f;
#define ROT2(j, W) { const h2_t cs = as_h2(W); const float a = x[2 * (j)], b = x[2 * (j) + 1], co = (float)cs.x, si = (float)cs.y; x[2 * (j)] = (a * co - b * si) * f; x[2 * (j) + 1] = (a * si + b * co) * f; }
            ROT2(0, c.ta.x) ROT2(1, c.ta.y) ROT2(2, c.ta.z) ROT2(3, c.ta.w)
#undef ROT2
        } else if (seg == 3) {
#pragma unroll
            for (int j = 0; j < 8; j += 2) { const f32x2 xv = (f32x2){x[j], x[j + 1]}, sv = xv * sigmoid2(xv); x[j] = sv.x; x[j + 1] = sv.y; }
        } else if (seg == 4 || seg == 5) {
            const int d0 = col0 & 63;
            float y[8];
#pragma unroll
            for (int j = 0; j < 8; ++j) y[j] = __shfl_xor(x[j], 16);
            if (d0 < 16) {
#define ROPE1(j, W) { const h2_t cs = as_h2(W); const float co = (float)cs.x, si = (float)cs.y; x[j] = d0 == 0 ? x[j] * co - y[j] * si : x[j] * co + y[j] * si; }
                ROPE1(0, c.ta.x) ROPE1(1, c.ta.y) ROPE1(2, c.ta.z) ROPE1(3, c.ta.w) ROPE1(4, c.tb.x) ROPE1(5, c.tb.y) ROPE1(6, c.tb.z) ROPE1(7, c.tb.w)
#undef ROPE1
            }
            if (seg == 4) {
#pragma unroll
                for (int j = 0; j < 8; ++j) x[j] *= C2;
            }
        }
        u32x4 w; w.x = pk2(x[0], x[1]); w.y = pk2(x[2], x[3]); w.z = pk2(x[4], x[5]); w.w = pk2(x[6], x[7]);
        *(u32x4*)(proj + (size_t)row * DIN + col0) = w;
    }
};

template <bool PAIRED, class Epi>
__device__ __forceinline__ void gemm_naive(const bf16* A, int lda, const bf16* Bt, int M, int N, int K, const Epi& E, int gw, int ngw, int lane) {
    const int fr = lane & 15, fq = lane >> 4;
    const int ngrp = PAIRED ? N / 64 : N / 32;
    const int nitems = (M / 16) * ngrp;
    for (int it = gw; it < nitems; it += ngw) {
        const int rb = it / ngrp, cg = it % ngrp;
        int col0;
        if (PAIRED) { const int oc = cg * 32; col0 = (oc / 128) * 256 + (oc % 128); } else col0 = cg * 32;
        f32x4 acc[4];
#pragma unroll
        for (int n = 0; n < 4; ++n) acc[n] = (f32x4){0.f, 0.f, 0.f, 0.f};
        const bf16* ap = A + (size_t)(rb * 16 + fr) * lda + fq * 8;
        const bf16* bp0 = Bt + (size_t)(col0 + perm32(fr)) * K + fq * 8;
        const bf16* bp1 = Bt + (size_t)(col0 + perm32(16 + fr)) * K + fq * 8;
        for (int k = 0; k < K; k += 32) {
            const bf16x8 a = *(const bf16x8*)(ap + k);
            const bf16x8 b0 = *(const bf16x8*)(bp0 + k), b1 = *(const bf16x8*)(bp1 + k);
            acc[0] = __builtin_amdgcn_mfma_f32_16x16x32_bf16(b0, a, acc[0], 0, 0, 0);
            acc[1] = __builtin_amdgcn_mfma_f32_16x16x32_bf16(b1, a, acc[1], 0, 0, 0);
            if (PAIRED) {
                const bf16x8 b2 = *(const bf16x8*)(bp0 + (size_t)128 * K + k), b3 = *(const bf16x8*)(bp1 + (size_t)128 * K + k);
                acc[2] = __builtin_amdgcn_mfma_f32_16x16x32_bf16(b2, a, acc[2], 0, 0, 0);
                acc[3] = __builtin_amdgcn_mfma_f32_16x16x32_bf16(b3, a, acc[3], 0, 0, 0);
            }
        }
        const int row = rb * 16 + fr;
        if constexpr (PAIRED) { const auto c = E.load(row, cg * 32 + 8 * fq); E.pair(row, cg * 32 + 8 * fq, c, acc[0], acc[1], acc[2], acc[3]); }
        else { const auto c = E.load(row, col0 + 8 * fq); E.row8(row, col0 + 8 * fq, c, acc[0], acc[1]); }
    }
}

namespace pg8 {
#define PG8_LAS __attribute__((address_space(3)))
typedef unsigned short bf16_t;
constexpr int BM = 256, BK = 64, HALF = 128, HTB = HALF * BK * 2  , STAGE_BYTES = 8 * HTB, NXCD = 8, WGM = 8;

__host__ __device__ __forceinline__ int lds_byte(int r, int c) { const int st = (r >> 4) * 2 + (c >> 5), rr = r & 15, cc = c & 31, ob = rr * 64 + cc * 2; return st * 1024 + (ob ^ (((ob >> 9) & 1) << 5)); }
__host__ __device__ __forceinline__ void stage_rc(int b, int& R, int& C) { const int st = b / 1024, sb = b % 1024, swz = sb ^ (((sb >> 9) & 1) << 5); R = (st >> 1) * 16 + swz / 64; C = (st & 1) * 32 + (swz % 64) / 2; }

struct Unit { int pm, pn; };
struct Gemm { const bf16_t* A; const bf16_t* Bt; int M, N, K, lda; };

struct StaticOrder {
    int nM, nN, nwg, G, c;
    __host__ __device__ void init(int M, int N, int G_, int c_) { nM = M / BM; nN = N / BM; nwg = nM * nN; G = G_; c = c_; }
    __host__ __device__ bool next(int i, Unit& u) const {
        const long L = (long)i * G + c; if (L >= nwg) return false;
        int wgid = (int)L; { const int q = nwg / NXCD, r = nwg % NXCD, xcd = wgid % NXCD, off = wgid / NXCD; wgid = (xcd < r ? xcd * (q + 1) : r * (q + 1) + (xcd - r) * q) + off; }
        const int nig = WGM * nN, gid = wgid / nig, fm = gid * WGM, gsz = (nM - fm) < WGM ? (nM - fm) : WGM;
        u.pm = fm + ((wgid % nig) % gsz); u.pn = (wgid % nig) / gsz; return true;
    }
    __device__ __forceinline__ void a_ready(const Unit&) const {}
    __device__ __forceinline__ void done(const Unit&) const {}
};

template <class Epi, class Sched, bool ALIGN_EPI = false, bool SP2 = false>
__device__ __forceinline__ void gemm_phase(PG8_LAS unsigned char* lds, const Gemm g, const Sched& S, const Epi& E) {
    const int tid = threadIdx.x, wid = __builtin_amdgcn_readfirstlane(tid >> 6), lane = tid & 63, wr = wid >> 2, wc = wid & 3, fr = lane & 15, fq = lane >> 4;
    const int K = g.K, nt = K / BK, lda = g.lda;
    unsigned voffA[2], voffB[2];
#pragma unroll
    for (int i = 0; i < 2; ++i) { int R, C; stage_rc(tid * 16 + i * 8192, R, C); const int Rb = Epi::PERM ? ((R & ~31) + perm32(R & 31)) : R;
        voffA[i] = (unsigned)(R * lda + C) * 2u; voffB[i] = (unsigned)(Rb * K + C) * 2u; }
    const size_t kstep = (size_t)(BK * 2);
    const size_t hstep = (size_t)HALF * K * 2, hstepA = (size_t)HALF * lda * 2;
    const size_t tstep = 2 * hstep, tstepA = 2 * hstepA;
    const unsigned ldsw = (unsigned)wid * 1024u;
    const int aoff = lds_byte(wr * 64 + fr, fq * 8), boff = lds_byte(wc * 32 + fr, fq * 8);
#define PG8_SA(b, h) (((b) * 2 + (h)) * HTB)
#define PG8_SB(b, h) ((4 + (b) * 2 + (h)) * HTB)
#define PG8_STAGE(bufoff, gbase, voff) do { _Pragma("unroll") for (int _i = 0; _i < 2; ++_i) \
        __builtin_amdgcn_global_load_lds((const unsigned*)((const char*)(gbase) + (voff)[_i]), (PG8_LAS unsigned*)(lds + (bufoff) + ldsw + _i * 8192), 16, 0, 0); } while (0)
#define PG8_LDA(dst, b, h) do { _Pragma("unroll") for (int m = 0; m < 4; ++m) _Pragma("unroll") for (int k = 0; k < 2; ++k) dst[m][k] = *(const PG8_LAS bf16x8*)(lds + PG8_SA(b, h) + aoff + m * 2048 + k * 1024); } while (0)
#define PG8_LDB(dst, b, h) do { _Pragma("unroll") for (int n = 0; n < 2; ++n) _Pragma("unroll") for (int k = 0; k < 2; ++k) dst[n][k] = *(const PG8_LAS bf16x8*)(lds + PG8_SB(b, h) + boff + n * 2048 + k * 1024); } while (0)
#define PG8_MMA(ai, bj, At, Bt) do { __builtin_amdgcn_s_setprio(1); _Pragma("unroll") for (int m = 0; m < 4; ++m) _Pragma("unroll") for (int n = 0; n < 2; ++n) _Pragma("unroll") for (int k = 0; k < 2; ++k) \
        acc[ai][bj][m][n] = __builtin_amdgcn_mfma_f32_16x16x32_bf16(Bt[n][k], At[m][k], acc[ai][bj][m][n], 0, 0, 0); __builtin_amdgcn_s_setprio(0); } while (0)
#define PG8_WAIT_V(n) asm volatile("s_waitcnt vmcnt(" #n ")" ::: "memory")
#define PG8_WAIT_L(n) asm volatile("s_waitcnt lgkmcnt(" #n ")" ::: "memory")
#define PG8_BAR __builtin_amdgcn_s_barrier()
#define PG8_SCHED __builtin_amdgcn_sched_barrier(0)
    Unit cur, nxt; int ui = 0;
    if (!S.next(0, cur)) return;
    f32x4 acc[2][2][4][2];
#pragma unroll
    for (int a = 0; a < 2; ++a)
#pragma unroll
        for (int b = 0; b < 2; ++b)
#pragma unroll
            for (int m = 0; m < 4; ++m)
#pragma unroll
                for (int n = 0; n < 2; ++n) acc[a][b][m][n] = (f32x4){0.f, 0.f, 0.f, 0.f};
    bf16x8 At[4][2], B0[2][2], B1[2][2];
    const char* cA = (const char*)g.A + (size_t)cur.pm * tstepA; const char* cB = (const char*)g.Bt + (size_t)cur.pn * tstep;
    S.a_ready(cur);
    if constexpr (SP2) {
        PG8_STAGE(PG8_SB(0, 0), cB, voffB); PG8_STAGE(PG8_SB(0, 1), cB + hstep, voffB); PG8_STAGE(PG8_SA(0, 0), cA, voffA); PG8_STAGE(PG8_SA(0, 1), cA + hstepA, voffA);
        if (wr == 1) PG8_BAR;
        PG8_WAIT_V(2); PG8_BAR;
        PG8_STAGE(PG8_SB(1, 0), cB + kstep, voffB); PG8_STAGE(PG8_SA(1, 0), cA + kstep, voffA); PG8_STAGE(PG8_SB(1, 1), cB + hstep + kstep, voffB);
        PG8_WAIT_V(6); PG8_BAR;
    } else {
        PG8_STAGE(PG8_SB(0, 0), cB, voffB); PG8_STAGE(PG8_SA(0, 0), cA, voffA); PG8_STAGE(PG8_SB(0, 1), cB + hstep, voffB); PG8_STAGE(PG8_SA(0, 1), cA + hstepA, voffA);
        if (wr == 1) PG8_BAR;
        PG8_WAIT_V(4); PG8_BAR;
        PG8_STAGE(PG8_SB(1, 0), cB + kstep, voffB); PG8_STAGE(PG8_SA(1, 0), cA + kstep, voffA); PG8_STAGE(PG8_SB(1, 1), cB + hstep + kstep, voffB);
        PG8_WAIT_V(6); PG8_BAR;
    }
    for (;;) {
        const bool has_next = S.next(ui + 1, nxt);
        const char* nA = has_next ? (const char*)g.A + (size_t)nxt.pm * tstepA : cA; const char* nB = has_next ? (const char*)g.Bt + (size_t)nxt.pn * tstep : cB;
        for (int t = 0; t < nt; t += 2) {
            const bool last = (t == nt - 2);
            const char* a1 = cA + (size_t)(t + 1) * kstep;
            const char* a2 = last ? nA : cA + (size_t)(t + 2) * kstep; const char* b2 = last ? nB : cB + (size_t)(t + 2) * kstep;
            const char* a3 = a2 + kstep; const char* b3 = b2 + kstep;
            if (last && has_next) S.a_ready(nxt);
            if constexpr (SP2) {
            PG8_LDB(B0, 0, 0); PG8_LDB(B1, 0, 1); PG8_SCHED; PG8_LDA(At, 0, 0); PG8_STAGE(PG8_SA(1, 1), a1 + hstepA, voffA);
            PG8_WAIT_V(8); PG8_WAIT_L(0); PG8_BAR; PG8_MMA(0, 0, At, B0); PG8_MMA(0, 1, At, B1); PG8_BAR; PG8_SCHED;
            PG8_LDA(At, 0, 1); PG8_STAGE(PG8_SB(0, 0), b2, voffB); PG8_STAGE(PG8_SB(0, 1), b2 + hstep, voffB); PG8_STAGE(PG8_SA(0, 0), a2, voffA);
            PG8_WAIT_V(8); PG8_WAIT_L(0); PG8_BAR; PG8_MMA(1, 0, At, B0); PG8_MMA(1, 1, At, B1); PG8_BAR; PG8_SCHED;
            PG8_LDB(B0, 1, 0); PG8_LDB(B1, 1, 1); PG8_SCHED; PG8_LDA(At, 1, 0); PG8_STAGE(PG8_SA(0, 1), a2 + hstepA, voffA);
            PG8_WAIT_V(8); PG8_WAIT_L(0); PG8_BAR; PG8_MMA(0, 0, At, B0); PG8_MMA(0, 1, At, B1); PG8_BAR; PG8_SCHED;
            PG8_LDA(At, 1, 1); PG8_STAGE(PG8_SB(1, 0), b3, voffB); PG8_STAGE(PG8_SB(1, 1), b3 + hstep, voffB); PG8_STAGE(PG8_SA(1, 0), a3, voffA);
            PG8_WAIT_V(8); PG8_WAIT_L(0); PG8_BAR; PG8_MMA(1, 0, At, B0); PG8_MMA(1, 1, At, B1); PG8_BAR; PG8_SCHED;
            } else {
            PG8_LDB(B0, 0, 0); PG8_SCHED; PG8_LDA(At, 0, 0); PG8_STAGE(PG8_SA(1, 1), a1 + hstepA, voffA);
            PG8_WAIT_L(8); PG8_BAR; PG8_WAIT_L(0); PG8_MMA(0, 0, At, B0); PG8_BAR; PG8_SCHED;
            PG8_LDB(B1, 0, 1); PG8_STAGE(PG8_SB(0, 0), b2, voffB);
            PG8_BAR; PG8_WAIT_L(0); PG8_MMA(0, 1, At, B1); PG8_BAR;
            PG8_LDA(At, 0, 1); PG8_STAGE(PG8_SA(0, 0), a2, voffA);
            PG8_BAR; PG8_WAIT_L(0); PG8_MMA(1, 0, At, B0); PG8_BAR; PG8_SCHED;
            PG8_STAGE(PG8_SB(0, 1), b2 + hstep, voffB);
            PG8_WAIT_V(6); PG8_BAR; PG8_MMA(1, 1, At, B1); PG8_BAR;
            PG8_LDB(B0, 1, 0); PG8_SCHED; PG8_LDA(At, 1, 0); PG8_STAGE(PG8_SA(0, 1), a2 + hstepA, voffA);
            PG8_WAIT_L(8); PG8_BAR; PG8_WAIT_L(0); PG8_MMA(0, 0, At, B0); PG8_BAR; PG8_SCHED;
            PG8_LDB(B1, 1, 1); PG8_STAGE(PG8_SB(1, 0), b3, voffB);
            PG8_BAR; PG8_WAIT_L(0); PG8_MMA(0, 1, At, B1); PG8_BAR;
            PG8_LDA(At, 1, 1); PG8_STAGE(PG8_SA(1, 0), a3, voffA);
            PG8_BAR; PG8_WAIT_L(0); PG8_MMA(1, 0, At, B0); PG8_BAR; PG8_SCHED;
            PG8_STAGE(PG8_SB(1, 1), b3 + hstep, voffB);
            PG8_WAIT_V(6); PG8_BAR; PG8_MMA(1, 1, At, B1); PG8_BAR;
            }
        }
        if constexpr (ALIGN_EPI) { if (wr == 0) PG8_BAR; }
        if constexpr (!Epi::AFTER_DRAIN) { E(acc, cur, wr, wc, fr, fq); S.done(cur); }
        if (!has_next) break;
#pragma unroll
        for (int a = 0; a < 2; ++a)
#pragma unroll
            for (int b = 0; b < 2; ++b)
#pragma unroll
                for (int m = 0; m < 4; ++m)
#pragma unroll
                    for (int n = 0; n < 2; ++n) acc[a][b][m][n] = (f32x4){0.f, 0.f, 0.f, 0.f};
        cur = nxt; cA = nA; cB = nB; ++ui;
        if constexpr (ALIGN_EPI) { if (wr == 1) PG8_BAR; }
    }
    PG8_WAIT_V(0);
    if constexpr (!ALIGN_EPI) { if (wr == 0) PG8_BAR; }
    PG8_BAR;
    if constexpr (Epi::AFTER_DRAIN) { E.fused(acc, cur, wr, wc, fr, fq, lds, wid, lane); S.done(cur); }
#undef PG8_SA
#undef PG8_SB
#undef PG8_STAGE
#undef PG8_LDA
#undef PG8_LDB
#undef PG8_MMA
#undef PG8_WAIT_V
#undef PG8_WAIT_L
#undef PG8_BAR
#undef PG8_SCHED
}
}

template <bool PAIRED, class Epi>
__device__ __forceinline__ void gemm_meta(LAS unsigned char* lds, const bf16* A, int lda, const bf16* Bt, int N, int K, const Epi& E, int first, int stride, int wave, int lane, unsigned* arrive = nullptr) {
    const int fr = lane & 15, fq = lane >> 4;
    const int ngrp = PAIRED ? N / 64 : N / 32, ksl = K / 8;
    if (first < 0) return;
    constexpr int NF = PAIRED ? 4 : 2;
    LAS f32x4* red = (LAS f32x4*)lds;
    for (int cg = first; cg < ngrp; cg += stride) {
        int col0;
        if (PAIRED) { const int oc = cg * 32; col0 = (oc / 128) * 256 + (oc % 128); } else col0 = cg * 32;
        f32x4 acc[NF];
#pragma unroll
        for (int n = 0; n < NF; ++n) acc[n] = (f32x4){0.f, 0.f, 0.f, 0.f};
        const bf16* ap = A + (size_t)(MROW0 + fr) * lda + wave * ksl + fq * 8;
        const bf16* bp0 = Bt + (size_t)(col0 + perm32(fr)) * K + wave * ksl + fq * 8;
        const bf16* bp1 = Bt + (size_t)(col0 + perm32(16 + fr)) * K + wave * ksl + fq * 8;
#pragma unroll 4
        for (int k = 0; k < ksl; k += 32) {
            const bf16x8 a = *(const bf16x8*)(ap + k);
            const bf16x8 b0 = *(const bf16x8*)(bp0 + k), b1 = *(const bf16x8*)(bp1 + k);
            acc[0] = __builtin_amdgcn_mfma_f32_16x16x32_bf16(b0, a, acc[0], 0, 0, 0);
            acc[1] = __builtin_amdgcn_mfma_f32_16x16x32_bf16(b1, a, acc[1], 0, 0, 0);
            if constexpr (PAIRED) {
                const bf16x8 b2 = *(const bf16x8*)(bp0 + (size_t)128 * K + k), b3 = *(const bf16x8*)(bp1 + (size_t)128 * K + k);
                acc[2] = __builtin_amdgcn_mfma_f32_16x16x32_bf16(b2, a, acc[2], 0, 0, 0);
                acc[3] = __builtin_amdgcn_mfma_f32_16x16x32_bf16(b3, a, acc[3], 0, 0, 0);
            }
        }
#pragma unroll
        for (int n = 0; n < NF; ++n) red[(wave * NF + n) * 64 + lane] = acc[n];
        __syncthreads();
        if (wave == 0) {
#pragma unroll
            for (int w = 1; w < 8; ++w)
#pragma unroll
                for (int n = 0; n < NF; ++n) acc[n] = acc[n] + red[(w * NF + n) * 64 + lane];
            const int row = MROW0 + fr;
            if constexpr (PAIRED) { const auto c = E.load(row, cg * 32 + 8 * fq); E.pair(row, cg * 32 + 8 * fq, c, acc[0], acc[1], acc[2], acc[3]); }
            else { const auto c = E.load(row, col0 + 8 * fq); E.row8(row, col0 + 8 * fq, c, acc[0], acc[1]); }
        }
        __syncthreads();
    }
    if (arrive && first < ngrp) {
        asm volatile("s_waitcnt vmcnt(0)" ::: "memory");
        __syncthreads();
        if (threadIdx.x == 0) { __builtin_amdgcn_fence(__ATOMIC_RELEASE, "agent"); asm volatile("s_waitcnt vmcnt(0)" ::: "memory");
            __hip_atomic_fetch_add(arrive, (unsigned)((ngrp - 1 - first) / stride + 1), __ATOMIC_RELAXED, __HIP_MEMORY_SCOPE_AGENT); }
    }
}
__device__ __forceinline__ void meta_wait(unsigned* cnt, unsigned need) {
    if (threadIdx.x == 0) {
        unsigned sp = 0;
        while (__hip_atomic_load(cnt, __ATOMIC_RELAXED, __HIP_MEMORY_SCOPE_AGENT) < need) { __builtin_amdgcn_s_sleep(2); if (++sp > (1u << 18)) break; }
        __builtin_amdgcn_fence(__ATOMIC_ACQUIRE, "agent"); asm volatile("s_waitcnt vmcnt(0)" ::: "memory");
    }
    __syncthreads();
}

template <class F> struct EpiRow8 {
    static constexpr bool PERM = true, AFTER_DRAIN = false; F f;
    __device__ __forceinline__ void operator()(const f32x4 (&acc)[2][2][4][2], const pg8::Unit& u, int wr, int wc, int fr, int fq) const {
        const int colb = u.pn * 256 + wc * 32 + 8 * fq;
#pragma unroll
        for (int ai = 0; ai < 2; ++ai)
#pragma unroll
            for (int mb = 0; mb < 4; mb += F::RB) {
                const int row0 = u.pm * 256 + ai * 128 + wr * 64 + fr;
                typename F::Ctx c[F::RB][F::PER_BJ ? 2 : 1];
#pragma unroll
                for (int m = 0; m < F::RB; ++m)
#pragma unroll
                    for (int bj = 0; bj < (F::PER_BJ ? 2 : 1); ++bj) c[m][bj] = f.load(row0 + (mb + m) * 16, colb + bj * 128);
#pragma unroll
                for (int m = 0; m < F::RB; ++m)
#pragma unroll
                    for (int bj = 0; bj < 2; ++bj) f.row8(row0 + (mb + m) * 16, colb + bj * 128, c[m][F::PER_BJ ? bj : 0], acc[ai][bj][mb + m][0], acc[ai][bj][mb + m][1]);
            }
    }
};
template <class F> struct EpiPair {
    static constexpr bool PERM = true, AFTER_DRAIN = false; F f;
    __device__ __forceinline__ void operator()(const f32x4 (&acc)[2][2][4][2], const pg8::Unit& u, int wr, int wc, int fr, int fq) const {
        const int oc = u.pn * 128 + wc * 32 + 8 * fq;
        typename F::Ctx c[2][4];
#pragma unroll
        for (int ai = 0; ai < 2; ++ai)
#pragma unroll
            for (int m = 0; m < 4; ++m) c[ai][m] = f.load(u.pm * 256 + ai * 128 + wr * 64 + m * 16 + fr, oc);
#pragma unroll
        for (int ai = 0; ai < 2; ++ai)
#pragma unroll
            for (int m = 0; m < 4; ++m) { const int row = u.pm * 256 + ai * 128 + wr * 64 + m * 16 + fr;
                f.pair(row, oc, c[ai][m], acc[ai][0][m][0], acc[ai][0][m][1], acc[ai][1][m][0], acc[ai][1][m][1]); }
    }
};

struct EpiFinalFused {
    static constexpr bool PERM = true, AFTER_DRAIN = true;
    const bf16* hb; float* out; const float* gw; unsigned* xch; unsigned* cnt  ; float scale;
    __device__ __forceinline__ void fused(f32x4 (&acc)[2][2][4][2], const pg8::Unit& u, int wr, int wc, int fr, int fq, LAS unsigned char* lds, int wid, int lane) const {
        LAS float* P = (LAS float*)lds;
        LAS float* S = (LAS float*)(lds + 4096);
        const int colb = u.pn * 256 + wc * 32 + 8 * fq;
#pragma unroll
        for (int ai = 0; ai < 2; ++ai) {
            u32x4 rw[4][2];
#pragma unroll
            for (int m = 0; m < 4; ++m)
#pragma unroll
                for (int bj = 0; bj < 2; ++bj) rw[m][bj] = *(const u32x4*)(hb + (size_t)(u.pm * 256 + ai * 128 + wr * 64 + m * 16 + fr) * D + colb + bj * 128);
#pragma unroll
            for (int m = 0; m < 4; ++m) {
                float s = 0.f;
#pragma unroll
                for (int bj = 0; bj < 2; ++bj) { const u32x4 w = rw[m][bj];
                    const f32x4 a = (f32x4){bflo(w.x), bfhi(w.x), bflo(w.y), bfhi(w.y)} + acc[ai][bj][m][0] * scale, b = (f32x4){bflo(w.z), bfhi(w.z), bflo(w.w), bfhi(w.w)} + acc[ai][bj][m][1] * scale;
                    acc[ai][bj][m][0] = a; acc[ai][bj][m][1] = b;
                    s += (a.x * a.x + a.y * a.y) + (a.z * a.z + a.w * a.w) + (b.x * b.x + b.y * b.y) + (b.z * b.z + b.w * b.w); }
                s += __shfl_xor(s, 16); s += __shfl_xor(s, 32);
                if (fq == 0) P[(ai * 128 + wr * 64 + m * 16 + fr) * 4 + wc] = s;
            }
        }
        asm volatile("s_waitcnt lgkmcnt(0)" ::: "memory"); __builtin_amdgcn_s_barrier(); asm volatile("" ::: "memory");
        const int row = wid * 32 + (lane & 31);
        if (lane < 32) {
            const float t = (P[row * 4 + 0] + P[row * 4 + 1]) + (P[row * 4 + 2] + P[row * 4 + 3]);
            __hip_atomic_store(xch + (size_t)(u.pm * 256 + row) * 4 + u.pn, __float_as_uint(t), __ATOMIC_RELAXED, __HIP_MEMORY_SCOPE_AGENT);
        }
        asm volatile("s_waitcnt vmcnt(0)" ::: "memory");
        if (lane == 0) __hip_atomic_fetch_add(cnt + 64 * u.pm, 1u, __ATOMIC_RELAXED, __HIP_MEMORY_SCOPE_AGENT);
        if (wid == 0) {
            unsigned sp = 0;
            while ((unsigned)__builtin_amdgcn_readfirstlane(__hip_atomic_load(cnt + 64 * u.pm, __ATOMIC_RELAXED, __HIP_MEMORY_SCOPE_AGENT)) < 32u) { __builtin_amdgcn_s_sleep(2); if (++sp > (1u << 18)) break; }
            __builtin_amdgcn_fence(__ATOMIC_ACQUIRE, "agent");
        }
        asm volatile("s_waitcnt vmcnt(0) lgkmcnt(0)" ::: "memory"); __builtin_amdgcn_s_barrier(); asm volatile("" ::: "memory");
        if (lane < 32) {
            const unsigned* sl = xch + (size_t)(u.pm * 256 + row) * 4;
            const float t0 = __uint_as_float(__hip_atomic_load(sl + 0, __ATOMIC_RELAXED, __HIP_MEMORY_SCOPE_AGENT)), t1 = __uint_as_float(__hip_atomic_load(sl + 1, __ATOMIC_RELAXED, __HIP_MEMORY_SCOPE_AGENT)),
                        t2 = __uint_as_float(__hip_atomic_load(sl + 2, __ATOMIC_RELAXED, __HIP_MEMORY_SCOPE_AGENT)), t3 = __uint_as_float(__hip_atomic_load(sl + 3, __ATOMIC_RELAXED, __HIP_MEMORY_SCOPE_AGENT));
            S[row] = rsqrtf(((t0 + t1) + (t2 + t3)) * (1.f / D) + EPS);
        }
        asm volatile("s_waitcnt vmcnt(0) lgkmcnt(0)" ::: "memory"); __builtin_amdgcn_s_barrier(); asm volatile("" ::: "memory");
        f32x4 g0[2], g1[2];
#pragma unroll
        for (int bj = 0; bj < 2; ++bj) { g0[bj] = *(const f32x4*)(gw + colb + bj * 128); g1[bj] = *(const f32x4*)(gw + colb + bj * 128 + 4); }
#pragma unroll
        for (int ai = 0; ai < 2; ++ai)
#pragma unroll
            for (int m = 0; m < 4; ++m) { const int r = ai * 128 + wr * 64 + m * 16 + fr; const float rs = S[r];
                float* op = out + (size_t)(u.pm * 256 + r) * D + colb;
#pragma unroll
                for (int bj = 0; bj < 2; ++bj) { *(f32x4*)(op + bj * 128) = acc[ai][bj][m][0] * rs * g0[bj]; *(f32x4*)(op + bj * 128 + 4) = acc[ai][bj][m][1] * rs * g1[bj]; } }
    }
};

template <bool PAIRED, class F>
__device__ __forceinline__ void gemm_fast(LAS unsigned char* lds, const bf16* A, int lda, const bf16* Bt, int M, int N, int K, const F& f, int G, int c) {
    pg8::Gemm g{A, Bt, M, N, K, lda}; pg8::StaticOrder S; S.init(M, N, G, c);
    if constexpr (PAIRED) { EpiPair<F> E{f}; pg8::gemm_phase<EpiPair<F>, pg8::StaticOrder, true, true>(lds, g, S, E); }
    else { EpiRow8<F> E{f}; pg8::gemm_phase<EpiRow8<F>, pg8::StaticOrder, true, true>(lds, g, S, E); }
}

#ifndef USE_NAIVE_GEMM
#define USE_NAIVE_GEMM 0
#endif
#if USE_NAIVE_GEMM
#define GEMM(PAIRED, A, lda, Bt, M, N, K, E) gemm_naive<PAIRED>(A, lda, Bt, M, N, K, E, gw, ngw, lane)
#else
#define GEMM(PAIRED, A, lda, Bt, M, N, K, E) gemm_fast<PAIRED>((LAS unsigned char*)lds, A, lda, Bt, NREAL, N, K, E, G, wg)
#endif

namespace attn_body {
using bf16=__hip_bfloat16;
using bf16x8=__attribute__((ext_vector_type(8)))short;
using s16x4=__attribute__((ext_vector_type(4)))short;
using f32x16=__attribute__((ext_vector_type(16)))float;
using u32x4=__attribute__((ext_vector_type(4)))unsigned;
constexpr int D=64,QP=3584,OPITCH=1024;
constexpr int NW=8,QBLK=32,QB=QBLK*NW,KVBLK=64;
__device__ __forceinline__ int crow(int r,int hi){return (r&3)+8*(r>>2)+4*hi;}
#define SBAR() __builtin_amdgcn_sched_barrier(0)
__device__ __forceinline__ void cmask(f32x16&p0,f32x16&p1,int jb,int qrel,int hi){
  const float NEG=-INFINITY; int kb=64*jb+4*hi;
  #pragma unroll
  for(int r=0;r<16;++r){int kv=kb+(r&3)+8*(r>>2); if(kv>qrel)p0[r]=NEG; if(kv+32>qrel)p1[r]=NEG;}
}

constexpr int NSLOT=3, SLOTB=8192;
constexpr int VSLOTB=2*SLOTB;
constexpr int LDS_K=0, LDS_V=NSLOT*SLOTB, LDS_WS=LDS_V+NSLOT*VSLOTB, LDS_OST=LDS_WS+NW*64*4, LDS_BYTES=LDS_OST+NW*4096;
constexpr float C2=0.125f*1.4426950408889634f;
__device__ __forceinline__ void glds16(const void*gsrc,unsigned lds_dst){unsigned keep;
  asm volatile("s_mov_b32 %0, m0\n\ts_mov_b32 m0, %2\n\ts_nop 0\n\tglobal_load_lds_dwordx4 %1, off\n\ts_mov_b32 m0, %0":"=&s"(keep):"v"(gsrc),"s"(lds_dst):"memory");}
__device__ __forceinline__ float max3f(float a,float b,float c){float r;asm("v_max3_f32 %0, %1, %2, %3":"=v"(r):"v"(a),"v"(b),"v"(c));return r;}
__device__ __forceinline__ float max2f(float a,float b){float r;asm("v_max_f32_e32 %0, %1, %2":"=v"(r):"v"(a),"v"(b));return r;}
__device__ __forceinline__ float fadd_s(float a,float b){float r;asm("v_add_f32_e32 %0, %1, %2":"=v"(r):"v"(a),"v"(b));return r;}
__device__ __forceinline__ float fsub_s(float a,float b){float r;asm("v_sub_f32_e32 %0, %1, %2":"=v"(r):"v"(a),"v"(b));return r;}
typedef float f32x2_t __attribute__((ext_vector_type(2))); typedef __bf16 bf16x2_t __attribute__((ext_vector_type(2)));
__device__ __forceinline__ unsigned cvtpk_s(float lo,float hi){f32x2_t v={lo,hi};bf16x2_t b=__builtin_convertvector(v,bf16x2_t);return __builtin_bit_cast(unsigned,b);}
#define WAIT_BAR(N) asm volatile("s_waitcnt vmcnt(" #N ") lgkmcnt(0)\n\ts_barrier":::"memory")

__device__ __forceinline__ void qkt(f32x16&p0,f32x16&p1,const char*Kslot,const bf16x8*qr,int r32,int hi){
  const char*kb=Kslot+hi*1024+r32*16;
  #pragma unroll
  for(int d0=0;d0<4;++d0){
    const bf16x8 b0=*reinterpret_cast<const bf16x8*>(kb+d0*2048);
    const bf16x8 b1=*reinterpret_cast<const bf16x8*>(kb+d0*2048+512);
    if(d0==0){p0=__builtin_amdgcn_mfma_f32_32x32x16_bf16(b0,qr[0],f32x16{},0,0,0);p1=__builtin_amdgcn_mfma_f32_32x32x16_bf16(b1,qr[0],f32x16{},0,0,0);}
    else{p0=__builtin_amdgcn_mfma_f32_32x32x16_bf16(b0,qr[d0],p0,0,0,0);p1=__builtin_amdgcn_mfma_f32_32x32x16_bf16(b1,qr[d0],p1,0,0,0);}}
}
typedef __attribute__((address_space(3))) const char* lds_cptr;
typedef short v4i16_t __attribute__((ext_vector_type(4)));
__device__ __forceinline__ void kload8(bf16x8*kf,lds_cptr kp){
  kf[0]=*(const __attribute__((address_space(3))) bf16x8*)(kp);      kf[1]=*(const __attribute__((address_space(3))) bf16x8*)(kp+512);
  kf[2]=*(const __attribute__((address_space(3))) bf16x8*)(kp+2048); kf[3]=*(const __attribute__((address_space(3))) bf16x8*)(kp+2560);
  kf[4]=*(const __attribute__((address_space(3))) bf16x8*)(kp+4096); kf[5]=*(const __attribute__((address_space(3))) bf16x8*)(kp+4608);
  kf[6]=*(const __attribute__((address_space(3))) bf16x8*)(kp+6144); kf[7]=*(const __attribute__((address_space(3))) bf16x8*)(kp+6656);
}
__device__ __forceinline__ void kload2(bf16x8*kf,lds_cptr kp,int j){ kf[2*j]=*(const __attribute__((address_space(3))) bf16x8*)(kp+j*2048); kf[2*j+1]=*(const __attribute__((address_space(3))) bf16x8*)(kp+j*2048+512); }
__device__ __forceinline__ s16x4 vtr(lds_cptr p){ return __builtin_bit_cast(s16x4,__builtin_amdgcn_ds_read_tr16_b64_v4i16((__attribute__((address_space(3))) v4i16_t*)p)); }
__device__ __forceinline__ float rowmax(const f32x16&p0,const f32x16&p1){
  float a=max3f(p0[0],p0[1],p1[0]),b=max3f(p0[2],p0[3],p1[1]);a=max3f(a,p1[2],p1[3]);
  #pragma unroll
  for(int r=4;r<16;r+=4){a=max3f(a,p0[r],p0[r+1]);b=max3f(b,p0[r+2],p0[r+3]);a=max3f(a,p1[r],p1[r+1]);b=max3f(b,p1[r+2],p1[r+3]);}
  const float m=max2f(a,b);
  auto rr=__builtin_amdgcn_permlane32_swap(__float_as_uint(m),__float_as_uint(m),false,false);
  return max2f(__uint_as_float(rr[0]),__uint_as_float(rr[1]));
}
__device__ __forceinline__ void pv(f32x16*o,int vb,bf16x8 pa0,bf16x8 pa1,bf16x8 pa2,bf16x8 pa3){
  #pragma unroll
  for(int d0=0;d0<4;++d0){s16x4 lo[4],hi[4];
    #pragma unroll
    for(int ks=0;ks<4;++ks){
      asm volatile("ds_read_b64_tr_b16 %0,%1 offset:%c2":"=&v"(lo[ks]):"v"(vb),"i"(d0*4096+ks*1024):"memory");
      asm volatile("ds_read_b64_tr_b16 %0,%1 offset:%c2":"=&v"(hi[ks]):"v"(vb),"i"(d0*4096+ks*1024+512):"memory");}
    asm volatile("s_waitcnt lgkmcnt(0)":::"memory");SBAR();
    #define PK(k) (bf16x8){lo[k][0],lo[k][1],lo[k][2],lo[k][3],hi[k][0],hi[k][1],hi[k][2],hi[k][3]}
    o[d0]=__builtin_amdgcn_mfma_f32_32x32x16_bf16(pa0,PK(0),o[d0],0,0,0);
    o[d0]=__builtin_amdgcn_mfma_f32_32x32x16_bf16(pa1,PK(1),o[d0],0,0,0);
    o[d0]=__builtin_amdgcn_mfma_f32_32x32x16_bf16(pa2,PK(2),o[d0],0,0,0);
    o[d0]=__builtin_amdgcn_mfma_f32_32x32x16_bf16(pa3,PK(3),o[d0],0,0,0);
    #undef PK
  }
}

#ifndef ATTN_STORE16
#define ATTN_STORE16(p,v) (*(u32x4*)(p)=(v))
#endif
template<int THRL> __device__ __forceinline__ void attn_unit(int qb,const bf16*Qu,const bf16*Km,const bf16*Kr,const bf16*Vr,bf16*Ou,char*shm){
  const int tid=threadIdx.x,lane=tid&63,r32=lane&31,hi=lane>>5; const int wid=__builtin_amdgcn_readfirstlane(tid>>6);
  const bf16*Qw=Qu+(long)(wid*QBLK)*QP;
  const unsigned lds0=(unsigned)(uintptr_t)shm;
  float*wsf=(float*)(shm+LDS_WS)+wid*64;
  const bf16*ksrc=Kr+(long)(lane-KVBLK)*QP+wid*8;
  const bf16*vsrc=Vr+(long)(16*(wid&3)+(lane>>2)-KVBLK)*QP+(wid>>2)*32+(lane&3)*8;
  const long off0=(long)(Km-Kr)+(long)KVBLK*QP;
  const unsigned kdst=lds0+LDS_K+wid*1024, vdst=lds0+LDS_V+wid*1024;
  #define DMA_K(t,slot) glds16(ksrc+(((t)==0)?off0:(long)(t)*KVBLK*QP),(unsigned)__builtin_amdgcn_readfirstlane(kdst+(slot)))
  #define DMA_V(t,slot) do{ const bf16*vs_=vsrc+(((t)==0)?off0:(long)(t)*KVBLK*QP); const unsigned vd_=(unsigned)__builtin_amdgcn_readfirstlane(vdst+2*(slot)); glds16(vs_,vd_); glds16(vs_+64,vd_+8192u); }while(0)
  const int vb0=(int)(lds0+LDS_V)+((lane>>4)&1)*32+(lane&3)*8+(4*hi+((lane&15)>>2))*64;
  const char*Kbase=shm+LDS_K; bf16x8 kf[8];
  const lds_cptr shm3=(lds_cptr)shm; const lds_cptr kp0=shm3+LDS_K+hi*1024+r32*16; const lds_cptr vp0=shm3+LDS_V+((lane>>4)&1)*32+(lane&3)*8+(4*hi+((lane&15)>>2))*64;
  const int NT=4*qb+5;
  DMA_K(0,0);DMA_V(0,0);DMA_K(1,SLOTB);
  bf16x8 qr[4];
  #pragma unroll
  for(int d0=0;d0<4;++d0)qr[d0]=*reinterpret_cast<const bf16x8*>(&Qw[(long)r32*QP+d0*16+hi*8]);
  float mhat=0.f,l_reg=0.f;f32x16 o[4];o[0]=f32x16{};o[1]=f32x16{};o[2]=f32x16{};o[3]=f32x16{};
  const int qrel=wid*QBLK+r32;
  #define CMASK(P0,P1,t) do{int jb_=(t)-(NT-4); if(jb_>=0)cmask(P0,P1,jb_,qrel,hi);}while(0)
  bool resc=false;
  #define START(P0,P1) do{ const float rm=rowmax(P0,P1); resc=false; mhat=rm; \
    _Pragma("unroll") for(int r=0;r<16;++r)P0[r]=__builtin_amdgcn_exp2f(P0[r]-mhat); }while(0)
  #define RESC() do{ if(resc){ asm volatile("s_waitcnt lgkmcnt(0)":::"memory"); \
      _Pragma("unroll") for(int d_=0;d_<4;++d_) _Pragma("unroll") for(int r=0;r<16;++r)o[d_][r]*=wsf[crow(r,hi)]; } }while(0)
  f32x16 pA0,pA1,pB0,pB1;
  int sl_prev=0,sl_cur=0,sl_next=SLOTB;
  #define ROT() do{sl_prev=sl_cur;sl_cur=sl_next;sl_next=(sl_next==(NSLOT-1)*SLOTB)?0:sl_next+SLOTB;}while(0)
  DMA_K(2,2*SLOTB);
  WAIT_BAR(3);
  qkt(pA0,pA1,Kbase,qr,r32,hi);asm volatile("s_nop 15\n\ts_nop 7":"+v"(pA0),"+v"(pA1));
  { _Pragma("unroll") for(int r=0;r<16;++r)pA0[r]=-INFINITY; _Pragma("unroll") for(int r=0;r<8;++r)pA1[r]=-INFINITY; }
  START(pA0,pA1);
  _Pragma("unroll") for(int r=0;r<16;++r)pA1[r]=__builtin_amdgcn_exp2f(pA1[r]-mhat);
  WAIT_BAR(0);
  DMA_K(3,0);DMA_V(1,SLOTB);
  ROT();
  kload8(kf,kp0+sl_cur);
  WAIT_BAR(3);
  s16x4 vlo[8],vhi[8]; u32x4 pw0,pw1,pw2,pw3;
  #define PKW(P,B) cvtpk_s(P[B],P[B+1])
  #define PAF(k) __builtin_bit_cast(bf16x8,pw##k)
  #define VFR(i) (bf16x8){vlo[i][0],vlo[i][1],vlo[i][2],vlo[i][3],vhi[i][0],vhi[i][1],vhi[i][2],vhi[i][3]}
  #define PIN(x) asm volatile("":"+v"(x))
  #define MX3(a,b,c) __builtin_fmaxf(__builtin_fmaxf((a),(b)),(c))
  #define GAPA(MF,A0,A1,A2,A3,W0,W1,PW) do{ MF; sacc+=A0; sacc+=A1; sacc+=A2; sacc+=A3; PIN(sacc); W0; W1; PIN(PW); SBAR(); }while(0)
  #define EX(v) __builtin_amdgcn_exp2f(v)
  #define GAPB(MF,X,B) do{ MF; { typedef float f2_ __attribute__((ext_vector_type(2))); f2_ t_={X[B],X[B+1]}; t_=t_-mhat; X[B]=EX(t_.x); X[B+1]=EX(t_.y); } PIN(X); SBAR(); }while(0)
  #define VRD2(i) do{ vlo[i]=vtr(vp_+((((i)>>2)+2)*4096+((i)&3)*1024)); vhi[i]=vtr(vp_+((((i)>>2)+2)*4096+((i)&3)*1024+512)); SBAR(); }while(0)
  #define VRD(i) do{ vlo[i]=vtr(vp_+(((i)>>2)*4096+((i)&3)*1024)); vhi[i]=vtr(vp_+(((i)>>2)*4096+((i)&3)*1024+512)); }while(0)
  #define KRD(G,j) do{ if(G){ kload2(kf,kp0+sl_next,j); SBAR(); } }while(0)
  #define STEP(C0,C1,P0,P1,t,GK,GV,GL) do{ SBAR(); \
    const lds_cptr vp_=vp0+2*sl_prev; \
    VRD(0); SBAR(); float sacc=(P0[0]+P0[1]); \
    GAPA(C0=__builtin_amdgcn_mfma_f32_32x32x16_bf16(kf[0],qr[0],f32x16{},0,0,0), P0[2],P0[3],P0[4],P0[5],     pw0[0]=PKW(P0,0), pw0[1]=PKW(P0,2), pw0); \
    VRD(4); SBAR(); GAPA(C1=__builtin_amdgcn_mfma_f32_32x32x16_bf16(kf[1],qr[0],f32x16{},0,0,0), P0[6],P0[7],P0[8],P0[9],     pw0[2]=PKW(P0,4), pw0[3]=PKW(P0,6), pw0); \
    VRD(1); SBAR(); GAPA(C0=__builtin_amdgcn_mfma_f32_32x32x16_bf16(kf[2],qr[1],C0,0,0,0),   P0[10],P0[11],P0[12],P0[13], pw1[0]=PKW(P0,8), pw1[1]=PKW(P0,10), pw1); \
    VRD(5); SBAR(); GAPA(C1=__builtin_amdgcn_mfma_f32_32x32x16_bf16(kf[3],qr[1],C1,0,0,0),   P0[14],P0[15],P1[0],P1[1],   pw1[2]=PKW(P0,12),pw1[3]=PKW(P0,14), pw1); \
    VRD(2); SBAR(); GAPA(C0=__builtin_amdgcn_mfma_f32_32x32x16_bf16(kf[4],qr[2],C0,0,0,0),   P1[2],P1[3],P1[4],P1[5],     pw2[0]=PKW(P1,0), pw2[1]=PKW(P1,2), pw2); \
    VRD(6); SBAR(); GAPA(C1=__builtin_amdgcn_mfma_f32_32x32x16_bf16(kf[5],qr[2],C1,0,0,0),   P1[6],P1[7],P1[8],P1[9],     pw2[2]=PKW(P1,4), pw2[3]=PKW(P1,6), pw2); \
    VRD(3); SBAR(); GAPA(C0=__builtin_amdgcn_mfma_f32_32x32x16_bf16(kf[6],qr[3],C0,0,0,0),   P1[10],P1[11],P1[12],P1[13], pw3[0]=PKW(P1,8), pw3[1]=PKW(P1,10), pw3); \
    VRD(7); SBAR(); GAPA(C1=__builtin_amdgcn_mfma_f32_32x32x16_bf16(kf[7],qr[3],C1,0,0,0),   P1[14],P1[15],0.f,0.f,       pw3[2]=PKW(P1,12),pw3[3]=PKW(P1,14), pw3); \
    l_reg+=sacc; \
    if(GK){DMA_K((t)+3,sl_cur);} if(GV){DMA_V((t)+1,sl_next);} \
    CMASK(C0,C1,t); \
    { float a=MX3(C0[0],C0[1],C1[0]),b=MX3(C0[2],C0[3],C1[1]); a=MX3(a,C1[2],C1[3]); \
      _Pragma("unroll") for(int r=4;r<16;r+=4){a=MX3(a,C0[r],C0[r+1]);b=MX3(b,C0[r+2],C0[r+3]);a=MX3(a,C1[r],C1[r+1]);b=MX3(b,C1[r+2],C1[r+3]);} \
      float rm=__builtin_fmaxf(a,b); { auto rr=__builtin_amdgcn_permlane32_swap(__float_as_uint(rm),__float_as_uint(rm),false,false); rm=__builtin_fmaxf(__uint_as_float(rr[0]),__uint_as_float(rr[1])); } \
      resc=false; \
      const float rmr=rm-mhat;                                         \
      if(__builtin_expect(__any(rmr>(float)THRL),0)){ const float dl=__builtin_fmaxf(rmr,0.f); mhat+=dl; \
        const float f=__builtin_amdgcn_exp2f(-dl); l_reg*=f; if(hi==0)wsf[r32]=f; resc=true; } } \
    SBAR(); \
    GAPB(o[0]=__builtin_amdgcn_mfma_f32_32x32x16_bf16(PAF(0),VFR(0),o[0],0,0,0), C0,0); VRD2(0); \
    GAPB(o[1]=__builtin_amdgcn_mfma_f32_32x32x16_bf16(PAF(0),VFR(4),o[1],0,0,0), C0,2); VRD2(4); \
    GAPB(o[0]=__builtin_amdgcn_mfma_f32_32x32x16_bf16(PAF(1),VFR(1),o[0],0,0,0), C0,4); VRD2(1); \
    GAPB(o[1]=__builtin_amdgcn_mfma_f32_32x32x16_bf16(PAF(1),VFR(5),o[1],0,0,0), C0,6); VRD2(5); \
    GAPB(o[0]=__builtin_amdgcn_mfma_f32_32x32x16_bf16(PAF(2),VFR(2),o[0],0,0,0), C0,8); VRD2(2); \
    GAPB(o[1]=__builtin_amdgcn_mfma_f32_32x32x16_bf16(PAF(2),VFR(6),o[1],0,0,0), C0,10); VRD2(6); \
    GAPB(o[0]=__builtin_amdgcn_mfma_f32_32x32x16_bf16(PAF(3),VFR(3),o[0],0,0,0), C0,12); VRD2(3); \
    GAPB(o[1]=__builtin_amdgcn_mfma_f32_32x32x16_bf16(PAF(3),VFR(7),o[1],0,0,0), C0,14); VRD2(7); \
    GAPB(o[2]=__builtin_amdgcn_mfma_f32_32x32x16_bf16(PAF(0),VFR(0),o[2],0,0,0), C1,0); \
    GAPB(o[3]=__builtin_amdgcn_mfma_f32_32x32x16_bf16(PAF(0),VFR(4),o[3],0,0,0), C1,2); \
    KRD(GL,0); GAPB(o[2]=__builtin_amdgcn_mfma_f32_32x32x16_bf16(PAF(1),VFR(1),o[2],0,0,0), C1,4); \
    KRD(GL,1); GAPB(o[3]=__builtin_amdgcn_mfma_f32_32x32x16_bf16(PAF(1),VFR(5),o[3],0,0,0), C1,6); \
    KRD(GL,2); GAPB(o[2]=__builtin_amdgcn_mfma_f32_32x32x16_bf16(PAF(2),VFR(2),o[2],0,0,0), C1,8); \
    KRD(GL,3); GAPB(o[3]=__builtin_amdgcn_mfma_f32_32x32x16_bf16(PAF(2),VFR(6),o[3],0,0,0), C1,10); \
    GAPB(o[2]=__builtin_amdgcn_mfma_f32_32x32x16_bf16(PAF(3),VFR(3),o[2],0,0,0), C1,12); \
    GAPB(o[3]=__builtin_amdgcn_mfma_f32_32x32x16_bf16(PAF(3),VFR(7),o[3],0,0,0), C1,14); \
    }while(0)
  int t=1;
  #undef CMASK
  #define CMASK(P0,P1,t) do{}while(0)
  for(;t+5<NT;t+=2){
    STEP(pB0,pB1,pA0,pA1,t,true,true,true);     WAIT_BAR(3); RESC(); ROT();
    STEP(pA0,pA1,pB0,pB1,t+1,true,true,true);   WAIT_BAR(3); RESC(); ROT();
  }
  #undef CMASK
  #define CMASK(P0,P1,t) do{int jb_=(t)-(NT-4); if(jb_>=0)cmask(P0,P1,jb_,qrel,hi);}while(0)
  #define ENDW(tt) do{ if((tt)+3<NT){WAIT_BAR(3);} else if((tt)+2<NT){WAIT_BAR(2);} else {WAIT_BAR(0);} }while(0)
  for(;t+1<NT;t+=2){
    STEP(pB0,pB1,pA0,pA1,t,(t+3<NT),(t+1<NT),(t+1<NT));       ENDW(t);   RESC(); ROT();
    STEP(pA0,pA1,pB0,pB1,t+1,(t+4<NT),(t+2<NT),(t+2<NT));     ENDW(t+1); RESC(); ROT();
  }
  { float sacc=pA0[0]+pA0[1]; _Pragma("unroll") for(int r=2;r<16;++r)sacc+=pA0[r]; _Pragma("unroll") for(int r=0;r<16;++r)sacc+=pA1[r]; l_reg+=sacc;
    pw0=(u32x4){PKW(pA0,0),PKW(pA0,2),PKW(pA0,4),PKW(pA0,6)};pw1=(u32x4){PKW(pA0,8),PKW(pA0,10),PKW(pA0,12),PKW(pA0,14)};pw2=(u32x4){PKW(pA1,0),PKW(pA1,2),PKW(pA1,4),PKW(pA1,6)};pw3=(u32x4){PKW(pA1,8),PKW(pA1,10),PKW(pA1,12),PKW(pA1,14)};
    SBAR(); pv(o,vb0+2*sl_prev,PAF(0),PAF(1),PAF(2),PAF(3)); }
  #undef PKW
  #undef PAF
  #undef VFR
  #undef PIN
  #undef MX3
  #undef GAPA
  #undef GAPB
  #undef EX
  #undef VRD
  #undef VRD2
  #undef KRD
  #undef STEP
  #undef ENDW
  {auto rr=__builtin_amdgcn_permlane32_swap(__float_as_uint(l_reg),__float_as_uint(l_reg),false,false);l_reg=__uint_as_float(rr[0])+__uint_as_float(rr[1]);}
  if(hi==0)wsf[32+r32]=l_reg;asm volatile("s_waitcnt lgkmcnt(0)":::"memory");
  float rli[16];
  #pragma unroll
  for(int r=0;r<16;++r)rli[r]=__builtin_amdgcn_rcpf(wsf[32+crow(r,hi)]);
  bf16*Ow=Ou+(long)(wid*QBLK)*OPITCH;
  { bf16*stg=(bf16*)(shm+LDS_OST)+wid*2048;
    #pragma unroll
    for(int dh=0;dh<2;++dh){
      #pragma unroll
      for(int r=0;r<16;++r){const int orow=crow(r,hi);
        #pragma unroll
        for(int d0=0;d0<2;++d0)stg[orow*64+d0*32+r32]=__float2bfloat16(o[2*dh+d0][r]*rli[r]);}
      asm volatile("s_waitcnt lgkmcnt(0)":::"memory");
      #pragma unroll
      for(int i=0;i<4;++i){const int row=i*8+(lane>>3),ch=lane&7; const u32x4 v=*(const u32x4*)(stg+row*64+ch*8); ATTN_STORE16(Ow+(long)row*OPITCH+dh*64+ch*8,v);}
      asm volatile("s_waitcnt lgkmcnt(0)":::"memory"); } }
  asm volatile("s_waitcnt lgkmcnt(0)\n\ts_barrier":::"memory");
  #undef DMA_K
  #undef DMA_V
  #undef CMASK
  #undef START
  #undef RESC
  #undef ROT
}
constexpr int ATTN_LDS_BYTES=LDS_BYTES;
#undef SBAR
#undef WAIT_BAR
}

__device__ __forceinline__ void stage_attn_fast(const Params& p, char* lds, int vcu, int G) {
    typedef attn_body::bf16 abf;
    const abf* proj = (const abf*)(p.ws + WS_PROJ); abf* OP = (abf*)(p.ws + WS_OP);
    for (int g = vcu; g < 256; g += G) {
        const int hh = g >> 2, s = g & 3, b = hh >> 3, h = (hh >> 1) & 3, m = hh & 1;
#pragma unroll 1
        for (int i = 0; i < 2; ++i) {
            const int qb = (i == 0) ? 7 - s : s;
            const size_t qrow = (size_t)b * SEQ + (size_t)qb * 256;
            attn_body::attn_unit<8>(qb, proj + qrow * DIN + SEG_DQ + h * 128 + m * 64,
                                    proj + (size_t)NREAL * DIN + SEG_DK + h * 128 + m * 64, proj + (size_t)b * SEQ * DIN + SEG_DK + h * 128 + m * 64,
                                    proj + (size_t)b * SEQ * DIN + SEG_DV + h * 128,
                                    OP + qrow * D + h * 256 + m * 128, lds);
        }
    }
}

constexpr int RET_RS = 272, RET_TS = 288;
constexpr int RET_K = 0, RET_V = 128 * RET_TS, RET_R = RET_V + 128 * RET_TS;
__device__ __forceinline__ int chunk_row(int b, int n, int j) { return n > 0 ? b * SEQ + 128 * (n - 1) + j : (j >= 112 ? MROW0 + j - 112 : -1); }
struct RetMat { u32x4 v[4]; };
__device__ __forceinline__ void ret_load_rows(RetMat& m, const bf16* src_col, int b, int n, int tid) {
#pragma unroll
    for (int k = 0; k < 4; ++k) { const int it = tid + 512 * k, j = it >> 4, ch = it & 15, r = chunk_row(b, n, j);
        m.v[k] = (u32x4){0u, 0u, 0u, 0u}; if (r >= 0) m.v[k] = *(const u32x4*)(src_col + (size_t)r * DIN + ch * 8); }
}
template <int ST> __device__ __forceinline__ void ret_put_rows(LAS unsigned char* dst, const RetMat& m, int tid) {
#pragma unroll
    for (int k = 0; k < 4; ++k) { const int it = tid + 512 * k, j = it >> 4, ch = it & 15; *(LAS u32x4*)(dst + j * ST + ch * 16) = m.v[k]; }
}
typedef short v4i16_t __attribute__((ext_vector_type(4)));
__device__ __forceinline__ bf16x8 ret_frag_tr(LAS unsigned char* m, int s, int cb, int lane) {
    LAS unsigned char* a = m + (32 * s + 4 * (lane >> 4) + ((lane & 15) >> 2)) * RET_TS + (16 * cb + 4 * (lane & 3)) * 2;
    const v4i16_t lo = __builtin_amdgcn_ds_read_tr16_b64_v4i16((LAS v4i16_t*)a), hi = __builtin_amdgcn_ds_read_tr16_b64_v4i16((LAS v4i16_t*)(a + 16 * RET_TS));
    return (bf16x8){lo[0], lo[1], lo[2], lo[3], hi[0], hi[1], hi[2], hi[3]};
}
__device__ __forceinline__ void stage_ret_scan(const Params& p, int gtid, int ngt) {
    const bf16* TT = (const bf16*)p.out; bf16* RP = (bf16*)(p.ws + WS_RP);
    for (int e = gtid; e < 32 * 4096; e += ngt) {
        const int bh = e >> 12, idx = e & 4095, h = bh & 3; const float g128 = exp2f(128.f * log2gamma(h));
        u32x2 tw[16];
#pragma unroll
        for (int n = 0; n < 16; ++n) tw[n] = *(const u32x2*)(TT + ((size_t)((n == 0 ? h : bh) * 16 + n) * 4096 + idx) * 4);
        f32x4 R = (f32x4){0.f, 0.f, 0.f, 0.f};
#pragma unroll
        for (int n = 0; n < 16; ++n) { const f32x4 t = (f32x4){bflo(tw[n].x), bfhi(tw[n].x), bflo(tw[n].y), bfhi(tw[n].y)}; R = (R + t) * g128;
            u32x2 wv; wv.x = pk2(R.x, R.y); wv.y = pk2(R.z, R.w); *(u32x2*)(RP + ((size_t)(bh * 16 + n) * 4096 + idx) * 4) = wv; }
    }
}
__device__ __forceinline__ void ret_state_ids(int u, int& bh, int& n) { if (u < 480) { bh = u / 15; n = 1 + u % 15; } else { bh = u - 480; n = 0; } }
__device__ __forceinline__ void ret_state_load(const Params& p, int u, int tid, RetMat& k, RetMat& v) {
    int bh, n; ret_state_ids(u, bh, n); const int b = bh >> 2, h = bh & 3;
    const bf16* proj = (const bf16*)(p.ws + WS_PROJ);
    ret_load_rows(k, proj + SEG_RK + h * 128, b, n, tid); ret_load_rows(v, proj + SEG_RV + h * 128, b, n, tid);
}
__device__ __forceinline__ void ret_state_compute(const Params& p, LAS unsigned char* lds, int u, int tid) {
    int bh, n; ret_state_ids(u, bh, n);
    bf16* TT = (bf16*)p.out + (size_t)(bh * 16 + n) * 16384;
    const int lane = tid & 63, w = tid >> 6, i = lane & 15, g = lane >> 4;
    f32x4 acc[8];
#pragma unroll
    for (int nf = 0; nf < 8; ++nf) acc[nf] = (f32x4){0.f, 0.f, 0.f, 0.f};
#pragma unroll
    for (int s = 0; s < 4; ++s) {
        const bf16x8 a = ret_frag_tr(lds + RET_V, s, w, lane);
#pragma unroll
        for (int nf = 0; nf < 8; ++nf) { const bf16x8 bb = ret_frag_tr(lds + RET_K, s, nf, lane);
            acc[nf] = __builtin_amdgcn_mfma_f32_16x16x32_bf16(bb, a, acc[nf], 0, 0, 0); }
    }
#pragma unroll
    for (int nf = 0; nf < 8; ++nf) { u32x2 wv; wv.x = pk2(acc[nf][0], acc[nf][1]); wv.y = pk2(acc[nf][2], acc[nf][3]); *(u32x2*)(TT + (16 * w + i) * 128 + 16 * nf + 4 * g) = wv; }
}
__device__ __forceinline__ void stage_ret_states(const Params& p, LAS unsigned char* lds, int first, int stride, int tid) {
    int u = first; if (u >= 484) return;
    RetMat k, v; ret_state_load(p, u, tid, k, v);
    for (;;) {
        ret_put_rows<RET_TS>(lds + RET_K, k, tid); ret_put_rows<RET_TS>(lds + RET_V, v, tid);
        __syncthreads();
        const int un = u + stride; const bool more = un < 484;
        if (more) ret_state_load(p, un, tid, k, v);
        ret_state_compute(p, lds, u, tid);
        __syncthreads();
        if (!more) break;
        u = un;
    }
}
struct RetOutRegs { RetMat k, v, r; };
__device__ __forceinline__ void ret_out_ids(int u, int& bh, int& c) { if (u < 512) { bh = u >> 4; c = 1 + (u & 15); } else { bh = u - 512; c = 0; } }
__device__ __forceinline__ void ret_out_load(const Params& p, int u, int tid, RetOutRegs& R) {
    int bh, c; ret_out_ids(u, bh, c); const int b = bh >> 2, h = bh & 3;
    const bf16* proj = (const bf16*)(p.ws + WS_PROJ); const bf16* RP = (const bf16*)(p.ws + WS_RP) + (size_t)(bh * 16 + (c > 0 ? c - 1 : 0)) * 16384;
    ret_load_rows(R.k, proj + SEG_RK + h * 128, b, c, tid); ret_load_rows(R.v, proj + SEG_RV + h * 128, b, c, tid);
#pragma unroll
    for (int k = 0; k < 4; ++k) { const int it = tid + 512 * k, j = it >> 4, ch = it & 15; R.r.v[k] = *(const u32x4*)(RP + j * 128 + ch * 8); }
}
__device__ __forceinline__ void ret_out_put(LAS unsigned char* lds, const RetOutRegs& R, int tid) {
    ret_put_rows<RET_RS>(lds + RET_K, R.k, tid); ret_put_rows<RET_TS>(lds + RET_V, R.v, tid); ret_put_rows<RET_RS>(lds + RET_R, R.r, tid);
}
__device__ __forceinline__ void ret_out_qload(const Params& p, int u, int tid, bf16x8 (&qf)[4]) {
    int bh, c; ret_out_ids(u, bh, c); const int b = bh >> 2, h = bh & 3;
    const bf16* proj = (const bf16*)(p.ws + WS_PROJ);
    const int lane = tid & 63, w = tid >> 6, i = lane & 15, g = lane >> 4;
    const int qrow = chunk_row(b, c, 16 * w + i), qr = qrow >= 0 ? qrow : MROW0;
#pragma unroll
    for (int s = 0; s < 4; ++s) qf[s] = *(const bf16x8*)(proj + (size_t)qr * DIN + SEG_RQ + h * 128 + 32 * s + 8 * g);
}
__device__ __forceinline__ void ret_out_compute(const Params& p, LAS unsigned char* lds, int u, int tid, const bf16x8 (&qfin)[4]) {
    int bh, c; ret_out_ids(u, bh, c); const int b = bh >> 2, h = bh & 3;
    bf16* proj = (bf16*)(p.ws + WS_PROJ);
    const int lane = tid & 63, w = tid >> 6, i = lane & 15, g = lane >> 4;
    const int q = 16 * w + i, qrow = chunk_row(b, c, q);
    bf16x8 qf[4];
#pragma unroll
    for (int s = 0; s < 4; ++s) qf[s] = qrow >= 0 ? qfin[s] : (bf16x8){0, 0, 0, 0, 0, 0, 0, 0};
    f32x4 st[8];
#pragma unroll
    for (int mf = 0; mf < 8; ++mf) {
        st[mf] = (f32x4){0.f, 0.f, 0.f, 0.f};
        if (mf <= w) {
#pragma unroll
            for (int s = 0; s < 4; ++s) { const bf16x8 a = *(const LAS bf16x8*)(lds + RET_K + (16 * mf + i) * RET_RS + (32 * s + 8 * g) * 2);
                st[mf] = __builtin_amdgcn_mfma_f32_16x16x32_bf16(a, qf[s], st[mf], 0, 0, 0); }
#pragma unroll
            for (int r = 0; r < 4; ++r) if (16 * mf + 4 * g + r > q) st[mf][r] = 0.f;
        }
    }
    bf16x8 pf[4];
#pragma unroll
    for (int s = 0; s < 4; ++s) { const u32x4 wv = (u32x4){pk2(st[2 * s][0], st[2 * s][1]), pk2(st[2 * s][2], st[2 * s][3]), pk2(st[2 * s + 1][0], st[2 * s + 1][1]), pk2(st[2 * s + 1][2], st[2 * s + 1][3])};
        pf[s] = __builtin_bit_cast(bf16x8, wv); }
    u32x2 gv[8];
    { const bf16* gq = proj + (size_t)(qrow >= 0 ? qrow : MROW0) * DIN + SEG_RG + h * 128 + 4 * g;
#pragma unroll
      for (int mf = 0; mf < 8; ++mf) gv[mf] = *(const u32x2*)(gq + 16 * mf); }
    f32x4 o[8];
#pragma unroll
    for (int mf = 0; mf < 8; ++mf) {
        o[mf] = (f32x4){0.f, 0.f, 0.f, 0.f};
#pragma unroll
        for (int s = 0; s < 4; ++s) {
            if (2 * s <= w) {
                o[mf] = __builtin_amdgcn_mfma_f32_16x16x32_bf16(ret_frag_tr(lds + RET_V, s, mf, lane), pf[s], o[mf], 0, 0, 0);
            }
        }
        if (c > 0) {
#pragma unroll
            for (int s = 0; s < 4; ++s) { const bf16x8 a = *(const LAS bf16x8*)(lds + RET_R + (16 * mf + i) * RET_RS + (32 * s + 8 * g) * 2);
                o[mf] = __builtin_amdgcn_mfma_f32_16x16x32_bf16(a, qf[s], o[mf], 0, 0, 0); }
        }
    }
    float sm = 0.f;
#pragma unroll
    for (int mf = 0; mf < 8; ++mf) sm += (o[mf][0] + o[mf][1]) + (o[mf][2] + o[mf][3]);
    sm += __shfl_xor(sm, 16); sm += __shfl_xor(sm, 32);
    const float mu = sm * (1.f / 128.f);
    float vr = 0.f;
#pragma unroll
    for (int mf = 0; mf < 8; ++mf) { o[mf] = o[mf] - mu; vr += (o[mf][0] * o[mf][0] + o[mf][1] * o[mf][1]) + (o[mf][2] * o[mf][2] + o[mf][3] * o[mf][3]); }
    vr += __shfl_xor(vr, 16); vr += __shfl_xor(vr, 32);
    const float rs = rsqrtf(vr * (1.f / 128.f) + EPS);
    if (qrow >= 0) {
        bf16* gp = proj + (size_t)qrow * DIN + SEG_RG + h * 128 + 4 * g;
#pragma unroll
        for (int mf = 0; mf < 8; ++mf) { u32x2 wv;
            wv.x = pk2(bflo(gv[mf].x) * o[mf][0] * rs, bfhi(gv[mf].x) * o[mf][1] * rs); wv.y = pk2(bflo(gv[mf].y) * o[mf][2] * rs, bfhi(gv[mf].y) * o[mf][3] * rs);
            *(u32x2*)(gp + 16 * mf) = wv; }
    }
}
__device__ __forceinline__ void stage_ret_outs(const Params& p, LAS unsigned char* lds, int first, int stride, int end, int tid) {
    int u = first; if (u >= end) return;
    RetOutRegs R; ret_out_load(p, u, tid, R);
    for (;;) {
        bf16x8 qf[4]; ret_out_qload(p, u, tid, qf);
        ret_out_put(lds, R, tid);
        __syncthreads();
        const int un = u + stride; const bool more = un < end;
        if (more) ret_out_load(p, un, tid, R);
        ret_out_compute(p, lds, u, tid, qf);
        __syncthreads();
        if (!more) break;
        u = un;
    }
}

__device__ __forceinline__ void attn_key(const float (&q)[64], const bf16* krow, const bf16* vrow, float& m, float& l, float (&o)[64]) {
    float s = 0.f;
#pragma unroll
    for (int c = 0; c < 8; ++c) {
        const u32x4 kk = *(const u32x4*)(krow + 8 * c);
        s += q[8 * c] * bflo(kk.x) + q[8 * c + 1] * bfhi(kk.x) + q[8 * c + 2] * bflo(kk.y) + q[8 * c + 3] * bfhi(kk.y)
           + q[8 * c + 4] * bflo(kk.z) + q[8 * c + 5] * bfhi(kk.z) + q[8 * c + 6] * bflo(kk.w) + q[8 * c + 7] * bfhi(kk.w);
    }
    const float mn = fmaxf(m, s), f = exp2f(m - mn), pp = exp2f(s - mn);
    m = mn; l = l * f + pp;
#pragma unroll
    for (int c = 0; c < 8; ++c) {
        const u32x4 vv = *(const u32x4*)(vrow + 8 * c);
        o[8 * c] = o[8 * c] * f + pp * bflo(vv.x); o[8 * c + 1] = o[8 * c + 1] * f + pp * bfhi(vv.x);
        o[8 * c + 2] = o[8 * c + 2] * f + pp * bflo(vv.y); o[8 * c + 3] = o[8 * c + 3] * f + pp * bfhi(vv.y);
        o[8 * c + 4] = o[8 * c + 4] * f + pp * bflo(vv.z); o[8 * c + 5] = o[8 * c + 5] * f + pp * bfhi(vv.z);
        o[8 * c + 6] = o[8 * c + 6] * f + pp * bflo(vv.w); o[8 * c + 7] = o[8 * c + 7] * f + pp * bfhi(vv.w);
    }
}
__device__ __forceinline__ void stage_attn_naive(const Params& p, int first, int wg, int nwg, int tid) {
    int vz; asm volatile("v_mov_b32 %0, 0" : "=v"(vz));
    const bf16* proj = (const bf16*)(p.ws + WS_PROJ) + vz; bf16* OP = (bf16*)(p.ws + WS_OP);
    for (int it = first + wg; it < 513; it += nwg) {
        int row, h, m, vh, b = 0, nreal, nmeta;
        if (it < 512) { b = it >> 6; h = (it >> 4) & 3; m = (it >> 3) & 1; vh = (it >> 2) & 1; const int t = (it & 3) * 512 + tid; row = b * SEQ + t; nreal = t + 1; nmeta = NMETA; }
        else { if (tid >= 256) continue; h = tid >> 6; m = (tid >> 5) & 1; vh = (tid >> 4) & 1; const int i = tid & 15; row = MROW0 + i; nreal = 0; nmeta = i + 1; }
        float q[64], o[64];
        const bf16* qp = proj + (size_t)row * DIN + SEG_DQ + h * 128 + m * 64;
#pragma unroll
        for (int c = 0; c < 8; ++c) { const u32x4 v = *(const u32x4*)(qp + 8 * c);
            q[8 * c] = bflo(v.x); q[8 * c + 1] = bfhi(v.x); q[8 * c + 2] = bflo(v.y); q[8 * c + 3] = bfhi(v.y); q[8 * c + 4] = bflo(v.z); q[8 * c + 5] = bfhi(v.z); q[8 * c + 6] = bflo(v.w); q[8 * c + 7] = bfhi(v.w); }
#pragma unroll
        for (int c = 0; c < 64; ++c) o[c] = 0.f;
        float mx = -1e30f, l = 0.f;
        const size_t koff = SEG_DK + h * 128 + m * 64, voff = SEG_DV + h * 128 + vh * 64;
        for (int j = 0; j < NMETA; ++j) if (j < nmeta) attn_key(q, proj + (size_t)(MROW0 + j) * DIN + koff, proj + (size_t)(MROW0 + j) * DIN + voff, mx, l, o);
        if (it < 512) {
            const int tmax = (it & 3) * 512 + 511;
            for (int j = 0; j <= tmax; ++j) if (j < nreal) attn_key(q, proj + (size_t)(b * SEQ + j) * DIN + koff, proj + (size_t)(b * SEQ + j) * DIN + voff, mx, l, o);
        }
        const float il = 1.f / l;
        bf16* op = OP + (size_t)row * D + h * 256 + m * 128 + vh * 64;
#pragma unroll
        for (int c = 0; c < 8; ++c) { u32x4 w; w.x = pk2(o[8 * c] * il, o[8 * c + 1] * il); w.y = pk2(o[8 * c + 2] * il, o[8 * c + 3] * il);
            w.z = pk2(o[8 * c + 4] * il, o[8 * c + 5] * il); w.w = pk2(o[8 * c + 6] * il, o[8 * c + 7] * il); *(u32x4*)(op + 8 * c) = w; }
    }
}
__device__ __forceinline__ void ret_key(const unsigned (&q)[64], const bf16* krow, const bf16* vrow, float cf, float (&o)[64]) {
    float s = 0.f;
#pragma unroll
    for (int c = 0; c < 16; ++c) {
        const u32x4 kk = *(const u32x4*)(krow + 8 * c);
        s += bflo(q[4 * c]) * bflo(kk.x) + bfhi(q[4 * c]) * bfhi(kk.x) + bflo(q[4 * c + 1]) * bflo(kk.y) + bfhi(q[4 * c + 1]) * bfhi(kk.y)
           + bflo(q[4 * c + 2]) * bflo(kk.z) + bfhi(q[4 * c + 2]) * bfhi(kk.z) + bflo(q[4 * c + 3]) * bflo(kk.w) + bfhi(q[4 * c + 3]) * bfhi(kk.w);
    }
    s *= cf;
#pragma unroll
    for (int c = 0; c < 8; ++c) {
        const u32x4 vv = *(const u32x4*)(vrow + 8 * c);
        o[8 * c] += s * bflo(vv.x); o[8 * c + 1] += s * bfhi(vv.x); o[8 * c + 2] += s * bflo(vv.y); o[8 * c + 3] += s * bfhi(vv.y);
        o[8 * c + 4] += s * bflo(vv.z); o[8 * c + 5] += s * bfhi(vv.z); o[8 * c + 6] += s * bflo(vv.w); o[8 * c + 7] += s * bfhi(vv.w);
    }
}
__device__ __forceinline__ void stage_ret_naive(const Params& p, int wg, int nwg, int tid) {
    int vz; asm volatile("v_mov_b32 %0, 0" : "=v"(vz));
    const bf16* proj = (const bf16*)(p.ws + WS_PROJ) + vz; float* RT = p.out;
    for (int it = wg; it < 257; it += nwg) {
        int row, h, vh, b = 0, nreal, nmeta, nq;
        if (it < 256) { b = it >> 5; h = (it >> 3) & 3; vh = (it >> 2) & 1; const int t = (it & 3) * 512 + tid; row = b * SEQ + t; nreal = t + 1; nmeta = NMETA; nq = 1 + (t >> 7); }
        else { if (tid >= 128) continue; h = tid >> 5; vh = (tid >> 4) & 1; const int i = tid & 15; row = MROW0 + i; nreal = 0; nmeta = i + 1; nq = 0; }
        unsigned q[64]; float o[64];
        const bf16* qp = proj + (size_t)row * DIN + SEG_RQ + h * 128;
#pragma unroll
        for (int c = 0; c < 16; ++c) { const u32x4 v = *(const u32x4*)(qp + 8 * c); q[4 * c] = v.x; q[4 * c + 1] = v.y; q[4 * c + 2] = v.z; q[4 * c + 3] = v.w; }
#pragma unroll
        for (int c = 0; c < 64; ++c) o[c] = 0.f;
        const size_t koff = SEG_RK + h * 128, voff = SEG_RV + h * 128 + vh * 64;
        const float lg128 = 128.f * log2gamma(h);
        { const float cf = exp2f(lg128 * (float)nq);
          for (int j = 0; j < NMETA; ++j) if (j < nmeta) ret_key(q, proj + (size_t)(MROW0 + j) * DIN + koff, proj + (size_t)(MROW0 + j) * DIN + voff, cf, o); }
        if (it < 256) {
            const int tmax = (it & 3) * 512 + 511;
            for (int j = 0; j <= tmax; ++j) if (j < nreal) { const float cf = exp2f(lg128 * (float)(nq - 1 - (j >> 7)));
                ret_key(q, proj + (size_t)(b * SEQ + j) * DIN + koff, proj + (size_t)(b * SEQ + j) * DIN + voff, cf, o); }
        }
        float* op = RT + (size_t)row * 512 + h * 128 + vh * 64;
#pragma unroll
        for (int c = 0; c < 16; ++c) *(f32x4*)(op + 4 * c) = (f32x4){o[4 * c], o[4 * c + 1], o[4 * c + 2], o[4 * c + 3]};
    }
}
__device__ __forceinline__ void stage_retnorm(const Params& p, int gw, int ngw, int lane) {
    const float* RT = (const float*)p.out; bf16* proj = (bf16*)(p.ws + WS_PROJ);
    for (int r = gw; r < NREAL + NMETA; r += ngw) {
        const int row = r < NREAL ? r : MROW0 + (r - NREAL);
        const int h = lane >> 4, c0 = (lane & 15) * 8;
        const f32x4 a = *(const f32x4*)(RT + (size_t)row * 512 + h * 128 + c0), b = *(const f32x4*)(RT + (size_t)row * 512 + h * 128 + c0 + 4);
        float o[8] = {a.x, a.y, a.z, a.w, b.x, b.y, b.z, b.w};
        float s = 0.f;
#pragma unroll
        for (int j = 0; j < 8; ++j) s += o[j];
        s += __shfl_xor(s, 1); s += __shfl_xor(s, 2); s += __shfl_xor(s, 4); s += __shfl_xor(s, 8);
        const float mu = s * (1.f / 128.f);
        float v = 0.f;
#pragma unroll
        for (int j = 0; j < 8; ++j) { o[j] -= mu; v += o[j] * o[j]; }
        v += __shfl_xor(v, 1); v += __shfl_xor(v, 2); v += __shfl_xor(v, 4); v += __shfl_xor(v, 8);
        const float rs = rsqrtf(v * (1.f / 128.f) + EPS);
        bf16* gp = proj + (size_t)row * DIN + SEG_RG + h * 128 + c0;
        const u32x4 g = *(const u32x4*)gp; u32x4 w;
        w.x = pk2(bflo(g.x) * o[0] * rs, bfhi(g.x) * o[1] * rs); w.y = pk2(bflo(g.y) * o[2] * rs, bfhi(g.y) * o[3] * rs);
        w.z = pk2(bflo(g.z) * o[4] * rs, bfhi(g.z) * o[5] * rs); w.w = pk2(bflo(g.w) * o[6] * rs, bfhi(g.w) * o[7] * rs);
        *(u32x4*)gp = w;
    }
}
__device__ __forceinline__ void stage_combine(const Params& p, int l, int gw, int ngw, int lane) {
    const bf16* OP = (const bf16*)(p.ws + WS_OP); bf16* proj = (bf16*)(p.ws + WS_PROJ);
    const float lam = ((const float*)(p.ws + WS_TAB + TAB_LAM))[l];
    const int h = lane >> 4, c0 = (lane & 15) * 8;
    constexpr int NR = NREAL + NMETA, U = 4;
    for (int r0 = gw; r0 < NR; r0 += ngw * U) {
        u32x4 a[U], b[U]; int row[U];
#pragma unroll
        for (int k = 0; k < U; ++k) { const int r = r0 + k * ngw, rr = r < NR ? r : gw; row[k] = rr < NREAL ? rr : MROW0 + (rr - NREAL);
            a[k] = *(const u32x4*)(OP + (size_t)row[k] * D + h * 256 + c0); b[k] = *(const u32x4*)(OP + (size_t)row[k] * D + h * 256 + 128 + c0); }
#pragma unroll
        for (int k = 0; k < U; ++k) {
            float d[8];
            d[0] = bflo(a[k].x) - lam * bflo(b[k].x); d[1] = bfhi(a[k].x) - lam * bfhi(b[k].x); d[2] = bflo(a[k].y) - lam * bflo(b[k].y); d[3] = bfhi(a[k].y) - lam * bfhi(b[k].y);
            d[4] = bflo(a[k].z) - lam * bflo(b[k].z); d[5] = bfhi(a[k].z) - lam * bfhi(b[k].z); d[6] = bflo(a[k].w) - lam * bflo(b[k].w); d[7] = bfhi(a[k].w) - lam * bfhi(b[k].w);
            float s = 0.f;
#pragma unroll
            for (int j = 0; j < 8; ++j) s += d[j] * d[j];
            s += __shfl_xor(s, 1); s += __shfl_xor(s, 2); s += __shfl_xor(s, 4); s += __shfl_xor(s, 8);
            const float rs = rsqrtf(s * (1.f / 128.f) + EPS);
            u32x4 w; w.x = pk2(d[0] * rs, d[1] * rs); w.y = pk2(d[2] * rs, d[3] * rs); w.z = pk2(d[4] * rs, d[5] * rs); w.w = pk2(d[6] * rs, d[7] * rs);
            if (r0 + k * ngw < NR) *(u32x4*)(proj + (size_t)row[k] * DIN + SEG_DQ + h * 128 + c0) = w;
        }
    }
}
__device__ __forceinline__ void stage_final(const Params& p, int gw, int ngw, int lane) {
    const u64* ss = (const u64*)(p.ws + WS_CTL + CTL_SS) + 6 * MP; const float* g = p.in[19];
    f32x4 gg[4];
#pragma unroll
    for (int j = 0; j < 4; ++j) gg[j] = *(const f32x4*)(g + 4 * lane + 256 * j);
    for (int r0 = gw; r0 < NREAL; r0 += 2 * ngw) {
        const int r1 = r0 + ngw < NREAL ? r0 + ngw : r0;
        float* h0 = p.out + (size_t)r0 * D; float* h1 = p.out + (size_t)r1 * D;
        const u64 s0 = ss[r0], s1 = ss[r1];
        f32x4 v0[4], v1[4];
#pragma unroll
        for (int j = 0; j < 4; ++j) { v0[j] = *(const f32x4*)(h0 + 4 * lane + 256 * j); v1[j] = *(const f32x4*)(h1 + 4 * lane + 256 * j); }
        const float rs0 = rsqrtf((float)s0 * SS_INV + EPS), rs1 = rsqrtf((float)s1 * SS_INV + EPS);
#pragma unroll
        for (int j = 0; j < 4; ++j) *(f32x4*)(h0 + 4 * lane + 256 * j) = v0[j] * rs0 * gg[j];
        if (r1 != r0) {
#pragma unroll
            for (int j = 0; j < 4; ++j) *(f32x4*)(h1 + 4 * lane + 256 * j) = v1[j] * rs1 * gg[j];
        }
    }
}

#ifndef XB_WG_REL
#define XB_WG_REL 0
#endif
#ifndef XB_STRONG_REL
#define XB_STRONG_REL 0
#endif
#ifndef XB_STRONG_ACQ
#define XB_STRONG_ACQ 0
#endif
#define XB_TMO      128
#define XB_XCNT(j)  (256  + 64 * (j))
#define XB_XSUB(j)  (1280 + 64 * (j))
#define XB_XGEN(j)  (2304 + 64 * (j))
#define XB_TOP      3328
#define XB_TOPGEN   3392
#define XCD_BAR_WORDS 3456
#define XB_SPIN_CAP (1u << 18)
__device__ __forceinline__ unsigned xb_ld(unsigned* p)              { return __hip_atomic_load(p, __ATOMIC_RELAXED, __HIP_MEMORY_SCOPE_AGENT); }
__device__ __forceinline__ unsigned xb_add(unsigned* p, unsigned v) { return __hip_atomic_fetch_add(p, v, __ATOMIC_RELAXED, __HIP_MEMORY_SCOPE_AGENT); }
__device__ __forceinline__ unsigned xb_xcc_id() { return (unsigned)__builtin_amdgcn_s_getreg((3 << 11) | 20) & 0xFu; }
#define XB_SPIN(cond, bar) do { unsigned _sp = 0; while (cond) { __builtin_amdgcn_s_sleep(1); \
    if ((++_sp & 255u) == 0u) { if (xb_ld(&(bar)[XB_TMO])) break; if (_sp > XB_SPIN_CAP) { atomicAdd(&(bar)[XB_TMO], 1u); break; } } } } while (0)
struct XcdBarrier { unsigned* bar; unsigned x; volatile LAS unsigned* st; };
__device__ __forceinline__ XcdBarrier xcd_barrier_post(unsigned* bar, volatile LAS unsigned* st) {
    XcdBarrier b; b.bar = bar; b.x = xb_xcc_id(); b.st = st;
    if (threadIdx.x == 0) (void)xb_add(&bar[XB_XCNT(b.x)], 1u);
    return b;
}
__device__ __forceinline__ void xcd_barrier_complete(unsigned* bar, unsigned x, unsigned& nloc, unsigned& nx) {
    const unsigned G = gridDim.x * gridDim.y * gridDim.z;
    unsigned sum, cnt, mine, sp = 0u;
    for (;;) {
        sum = 0u; cnt = 0u; mine = 0u;
#pragma unroll
        for (unsigned j = 0; j < 16; ++j) { const unsigned c = xb_ld(&bar[XB_XCNT(j)]); sum += c; cnt += (c > 0u) ? 1u : 0u; mine = (j == x) ? c : mine; }
        if (sum == G) break;
        __builtin_amdgcn_s_sleep(1);
        if ((++sp & 255u) == 0u) { if (xb_ld(&bar[XB_TMO])) break; if (sp > XB_SPIN_CAP) { atomicAdd(&bar[XB_TMO], 1u); break; } }
    }
    nloc = mine > 0u ? mine : 1u; nx = cnt > 0u ? cnt : 1u;
}
__device__ __forceinline__ void xcd_barrier(const XcdBarrier& b) {
    asm volatile("s_waitcnt vmcnt(0)" ::: "memory");
#if XB_STRONG_REL
    __builtin_amdgcn_fence(__ATOMIC_RELEASE, "agent");
    asm volatile("s_waitcnt vmcnt(0)" ::: "memory");
#endif
    __syncthreads();
    if (threadIdx.x == 0) {
        unsigned* bar = b.bar;
        __builtin_amdgcn_s_waitcnt(0);
#if XB_WG_REL
        __builtin_amdgcn_fence(__ATOMIC_RELEASE, "agent");
        asm volatile("s_waitcnt vmcnt(0)" ::: "memory");
#endif
        unsigned nloc = b.st[0], nx = b.st[1];
        if (nloc == 0u) { xcd_barrier_complete(bar, b.x, nloc, nx); b.st[0] = nloc; b.st[1] = nx; }
        const unsigned old = xb_add(&bar[XB_XSUB(b.x)], 1u);
        const unsigned gen = old / nloc;
        if (old + 1u == (gen + 1u) * nloc) {
            __builtin_amdgcn_fence(__ATOMIC_RELEASE, "agent");
            asm volatile("s_waitcnt vmcnt(0)" ::: "memory");
            const unsigned og = xb_add(&bar[XB_TOP], 1u);
            const unsigned tg = og / nx;
            if (og + 1u == (tg + 1u) * nx) xb_add(&bar[XB_TOPGEN], 1u);
            else XB_SPIN(xb_ld(&bar[XB_TOPGEN]) == tg, bar);
            __builtin_amdgcn_fence(__ATOMIC_ACQUIRE, "agent");
            xb_add(&bar[XB_XGEN(b.x)], 1u);
            asm volatile("s_waitcnt vmcnt(0)" ::: "memory");
        } else {
            XB_SPIN(xb_ld(&bar[XB_XGEN(b.x)]) == gen, bar);
            __builtin_amdgcn_fence(__ATOMIC_ACQUIRE, "agent");
            asm volatile("s_waitcnt vmcnt(0)" ::: "memory");
        }
    }
    __syncthreads();
#if XB_STRONG_ACQ
    __builtin_amdgcn_fence(__ATOMIC_ACQUIRE, "agent");
    asm volatile("s_waitcnt vmcnt(0)" ::: "memory");
    __syncthreads();
#endif
}

#ifndef MK_ONE_LAUNCH
#define MK_ONE_LAUNCH 1
#endif
constexpr int NTHREADS = 512, LDS_BYTES = 147456, RING_BYTES = 131072, MISC_OFF = RING_BYTES + 320;
constexpr int CW_BAR = 4096;
constexpr int CW_RET = 8192;
constexpr int CW_FIN = 12288;
static_assert(CW_BAR + XCD_BAR_WORDS <= CW_RET && CW_RET + 6 * 64 <= CW_FIN && (CW_FIN + 64 * 64) * 4 <= (int)CTL_MEMSET && CTL_MEMSET <= CTL_SS, "ctl map");
constexpr int NPHASES = 20;

__global__ void __launch_bounds__(NTHREADS, 2) k_mega(Params p) {
    extern __shared__ __attribute__((aligned(16))) unsigned char lds[];
    const int tid = threadIdx.x, lane = tid & 63, wave = __builtin_amdgcn_readfirstlane(tid >> 6);
    const int G = gridDim.x, wg = blockIdx.x, vcu = (G % 8 == 0) ? (wg % 8) * (G / 8) + wg / 8 : wg;
    const int gw = wg * 8 + wave, ngw = G * 8, gtid = wg * NTHREADS + tid, ngt = G * NTHREADS;
    u64* ssb = (u64*)(p.ws + WS_CTL + CTL_SS);
    bf16* hb = (bf16*)(p.ws + WS_HB); bf16* proj = (bf16*)(p.ws + WS_PROJ); bf16* act = (bf16*)(p.ws + WS_PROJ);
    unsigned char* wb = p.ws + WS_W; float* hm = (float*)(p.ws + WS_HM);
    LAS float* scr = (LAS float*)((LAS unsigned char*)lds + wave * 16384);
    volatile LAS unsigned* MISC = (volatile LAS unsigned*)((LAS unsigned char*)lds + MISC_OFF);
    if (tid < 32) MISC[tid] = 0u;
    __syncthreads();
    XcdBarrier bar = xcd_barrier_post((unsigned*)(p.ws + WS_CTL) + CW_BAR, MISC + 8);
#define PH(k, ...) do { if (p.ph_lo <= (k) && (k) < p.ph_hi) { __VA_ARGS__; if ((k) + 1 < p.ph_hi) xcd_barrier(bar); } } while (0)
    const int cw0 = (G - G / 2) > 64 ? 32 : 0;
    const int tw = (wg - G / 2 - cw0) * 8 + wave, ntw = (G - G / 2 - cw0) * 8;
    PH(0, stage_prologue(p, gw, ngw, lane, gtid, ngt); convert_set(p, 0, 1, scr, gw, ngw, lane));
    bf16* actm = (bf16*)(p.ws + WS_ACTM) - (size_t)MROW0 * FF;
    unsigned* mcnt = (unsigned*)(p.ws + WS_CTL) + CW_RET;
    const int tg = wg - G / 2, tgs = G - G / 2;
    const int pre1k = (tg >= 0 && tg < 32) ? tg : -1;
#define LAYER(l, pb) do { \
        PH(pb + 0, { EpiSwiGLU E{ssb + (3 * l) * MP, act}; EpiSwiGLU Em{ssb + (3 * l) * MP, actm}; \
            GEMM(true, hb, D, (const bf16*)(wb + W_GU1), MP, 2 * FF, D, E); \
            if (tg >= 0) { \
                if (l == 1) { EpiResidT<0> Ep{p.in[0], p.out, hm, hb, ssb + (3 * l) * MP, 0.5f}; gemm_meta<false>((LAS unsigned char*)lds, actm, FF, (const bf16*)(wb + W_D2), D, FF, Ep, pre1k, tgs, wave, lane, mcnt + (3 * l) * 64); } \
                if (tg >= cw0) convert_set(p, l, 2 | 4, scr, tw, ntw, lane); \
                if (l == 1) meta_wait(mcnt + (3 * l) * 64, 32u); \
                gemm_meta<true>((LAS unsigned char*)lds, hb, D, (const bf16*)(wb + W_GU1), 2 * FF, D, Em, tg, tgs, wave, lane); } }); \
        PH(pb + 1, { if (l == 0) { EpiResidT<1> E{p.in[0], p.out, hm, hb, ssb + (3 * l + 1) * MP, 0.5f}; GEMM(false, act, FF, (const bf16*)(wb + W_D1), MP, D, FF, E); } \
                     else { EpiResidT<0> E{p.in[0], p.out, hm, hb, ssb + (3 * l + 1) * MP, 0.5f}; GEMM(false, act, FF, (const bf16*)(wb + W_D1), MP, D, FF, E); } }); \
        PH(pb + 2, { EpiInProj E{ssb + (3 * l + 1) * MP, proj, (const h2_t*)(p.ws + WS_TAB), (const h2_t*)(p.ws + WS_TAB + TAB_P)}; \
            GEMM(false, hb, D, (const bf16*)(wb + W_IN), MP, DIN, D, E); \
            if (tg >= 0) { \
                if (l == 0) { EpiResidT<1> Ep{p.in[0], p.out, hm, hb, ssb + (3 * l + 1) * MP, 0.5f}; gemm_meta<false>((LAS unsigned char*)lds, actm, FF, (const bf16*)(wb + W_D1), D, FF, Ep, pre1k, tgs, wave, lane, mcnt + (3 * l + 1) * 64); } \
                else { EpiResidT<0> Ep{p.in[0], p.out, hm, hb, ssb + (3 * l + 1) * MP, 0.5f}; gemm_meta<false>((LAS unsigned char*)lds, actm, FF, (const bf16*)(wb + W_D1), D, FF, Ep, pre1k, tgs, wave, lane, mcnt + (3 * l + 1) * 64); } \
                if (tg >= cw0) convert_set(p, l, 8 | 16, scr, tw, ntw, lane); \
                meta_wait(mcnt + (3 * l + 1) * 64, 32u); \
                gemm_meta<false>((LAS unsigned char*)lds, hb, D, (const bf16*)(wb + W_IN), DIN, D, E, tg, tgs, wave, lane); } }); \
        PH(pb + 3, stage_attn_fast(p, (char*)lds, vcu, G); stage_attn_naive(p, 512, vcu == G - 1 ? 0 : 1, G, tid); \
                   stage_ret_states(p, (LAS unsigned char*)lds, vcu, G, tid); stage_ret_outs(p, (LAS unsigned char*)lds, 512 + ((vcu + G - 228) % G), G, 516, tid)); \
        PH(pb + 4, stage_ret_scan(p, gtid, ngt); stage_combine(p, l, gw, ngw, lane)); \
        PH(pb + 5, stage_ret_outs(p, (LAS unsigned char*)lds, vcu, G, 512, tid)); \
        PH(pb + 6, { EpiResidT<0> E{p.in[0], p.out, hm, hb, ssb + (3 * l + 2) * MP, 1.0f}; GEMM(false, proj + YCOL, DIN, (const bf16*)(wb + W_OUT), MP, D, D, E); }); \
        PH(pb + 7, { EpiSwiGLU E{ssb + (3 * l + 2) * MP, act}; EpiSwiGLU Em{ssb + (3 * l + 2) * MP, actm}; \
            GEMM(true, hb, D, (const bf16*)(wb + W_GU2), MP, 2 * FF, D, E); \
            if (tg >= 0) { \
                if (l == 0) { EpiResidT<0> Ep{p.in[0], p.out, hm, hb, ssb + (3 * l + 2) * MP, 1.0f}; gemm_meta<false>((LAS unsigned char*)lds, proj + YCOL, DIN, (const bf16*)(wb + W_OUT), D, D, Ep, pre1k, tgs, wave, lane, mcnt + (3 * l + 2) * 64); } \
                if (tg >= cw0) { convert_set(p, l, 32, scr, tw, ntw, lane); if (l == 0) convert_set(p, 1, 1, scr, tw, ntw, lane); } \
                if (l == 0) { meta_wait(mcnt + (3 * l + 2) * 64, 32u); gemm_meta<true>((LAS unsigned char*)lds, hb, D, (const bf16*)(wb + W_GU2), 2 * FF, D, Em, tg, tgs, wave, lane); } } }); \
        PH(pb + 8, { if (l == 0) { EpiResidT<0> E{p.in[0], p.out, hm, hb, ssb + (3 * l + 3) * MP, 0.5f}; GEMM(false, act, FF, (const bf16*)(wb + W_D2), MP, D, FF, E); } \
                     else if (G != 256) { EpiResidT<2> E{p.in[0], p.out, hm, hb, ssb + (3 * l + 3) * MP, 0.5f}; GEMM(false, act, FF, (const bf16*)(wb + W_D2), MP, D, FF, E); } \
                     else { EpiFinalFused E{hb, p.out, p.in[19], (unsigned*)(p.ws + WS_XCH), (unsigned*)(p.ws + WS_CTL) + CW_FIN, 0.5f}; \
                            pg8::Gemm g{act, (const bf16*)(wb + W_D2), NREAL, D, FF, FF}; pg8::StaticOrder S; S.init(NREAL, D, G, wg); pg8::gemm_phase<EpiFinalFused, pg8::StaticOrder, false, true>((LAS unsigned char*)lds, g, S, E); } }); \
    } while (0)
    LAYER(0, 1);
    LAYER(1, 10);
#undef LAYER
    if (G != 256) PH(19, stage_final(p, gw, ngw, lane));
#undef PH
}

extern "C" void kernel_launch(void* const* d_in, const int* in_sizes, int n_in, void* d_out, int out_size, void* d_ws, size_t ws_size, hipStream_t stream) {
    static int grid = 0;
    if (grid == 0) {
        if (n_in != 20 || out_size != NREAL * D || ws_size < WS_END) { fprintf(stderr, "kernel_launch: unexpected shapes (n_in %d out %d ws %zu)\n", n_in, out_size, ws_size); grid = -1; return; }
        int dev = 0, cus = 0, per_cu = 0;
        (void)hipGetDevice(&dev); (void)hipDeviceGetAttribute(&cus, hipDeviceAttributeMultiprocessorCount, dev);
        (void)hipFuncSetAttribute((const void*)k_mega, hipFuncAttributeMaxDynamicSharedMemorySize, LDS_BYTES);
        (void)hipOccupancyMaxActiveBlocksPerMultiprocessor(&per_cu, (const void*)k_mega, NTHREADS, LDS_BYTES);
        (void)hipGetLastError();
        if (per_cu < 1) { fprintf(stderr, "kernel_launch: occupancy query reports %d blocks per CU; nothing launched\n", per_cu); grid = -1; return; }
        grid = cus > 0 ? cus : 256;
    }
    if (grid < 0) return;
    (void)hipMemsetAsync((char*)d_ws + WS_CTL, 0, CTL_MEMSET, stream);
    Params p{};
    for (int i = 0; i < 20; ++i) p.in[i] = (const float*)d_in[i];
    p.out = (float*)d_out; p.ws = (unsigned char*)d_ws;
#if MK_ONE_LAUNCH
    p.ph_lo = 0; p.ph_hi = grid == 256 ? NPHASES - 1 : NPHASES;
    hipLaunchKernelGGL(k_mega, dim3(grid), dim3(NTHREADS), LDS_BYTES, stream, p);
#else
    for (int pc = 0; pc < NPHASES; ++pc) { p.ph_lo = pc; p.ph_hi = pc + 1; hipLaunchKernelGGL(k_mega, dim3(grid), dim3(NTHREADS), LDS_BYTES, stream, p); }
#endif
}
```
